# Optimizing an MI355X kernel written in HIP

```python
import math
import jax, jax.numpy as jnp
from jax import lax
import numpy as np

D_MODEL = 1024
BATCH = 8
SEQ = 2048
DEPTH = 2
DEC_BATCH = 128
DEC_SEQ = 4
PAST_LEN = 2048
PAGE_SIZE = 128

GDN_HEADS = 4
GDN_HEAD_DIM = 128
GDN_WIDTH = GDN_HEADS * GDN_HEAD_DIM
GDN_CONV = 4
GDN_CHUNK = 64
SC_WIDTH = 256
SC_CONV = 3
MOBA_HEADS = 4
MOBA_HEAD_DIM = 64
MOBA_WIDTH = MOBA_HEADS * MOBA_HEAD_DIM
MOBA_BLOCK = 256
MOBA_TOPK = 3
MOBA_QCHUNK = 64
MIX_WIDTH = GDN_WIDTH + SC_WIDTH + MOBA_WIDTH
PROJ_WIDTH = 4 * GDN_WIDTH + 2 * GDN_HEADS + 3 * SC_WIDTH + 3 * MOBA_WIDTH
D_FF = 2816
NORM_EPS = 1e-6
NEG_INF = -1e30

kernel_name = 'hymba_gdn_shortconv_moba_macaron_step'


def rms_norm(x, w):
    xf = x.astype(jnp.float32)
    y = xf * lax.rsqrt(jnp.mean(xf * xf, axis=-1, keepdims=True) + NORM_EPS)
    return (y * w.astype(jnp.float32)).astype(x.dtype)


def swiglu(x, w_gate, w_up, w_down):
    return (jax.nn.silu(x @ w_gate) * (x @ w_up)) @ w_down


def causal_conv(x, hist, w):
    width = w.shape[0]
    seq_len = x.shape[1]
    xp = jnp.concatenate([hist.astype(x.dtype), x], axis=1)
    y = xp[:, 0:seq_len] * w[0]
    for i in range(1, width):
        y = y + xp[:, i:i + seq_len] * w[i]
    return y, xp[:, xp.shape[1] - (width - 1):]


def l2_normalize(x):
    return x * lax.rsqrt(jnp.sum(x * x, axis=-1, keepdims=True) + NORM_EPS)


def split_projection(h):
    sizes = (GDN_WIDTH, GDN_WIDTH, GDN_WIDTH, GDN_WIDTH, GDN_HEADS, GDN_HEADS,
             SC_WIDTH, SC_WIDTH, SC_WIDTH, MOBA_WIDTH, MOBA_WIDTH, MOBA_WIDTH)
    outs = []
    off = 0
    for s in sizes:
        outs.append(h[..., off:off + s])
        off += s
    return outs


def gated_delta_rule(q, k, v, beta, g, s0):
    bsz, seq_len, n_heads, dk = q.shape
    cs = min(GDN_CHUNK, seq_len)
    n_chunks = -(-seq_len // cs)
    pad = n_chunks * cs - seq_len
    if pad:
        pw = ((0, 0), (0, pad), (0, 0), (0, 0))
        q, k, v = jnp.pad(q, pw), jnp.pad(k, pw), jnp.pad(v, pw)
        beta, g = jnp.pad(beta, pw[:3]), jnp.pad(g, pw[:3])

    def chunks(t):
        return t.reshape(bsz, n_chunks, cs, n_heads, -1).transpose(1, 0, 3, 2, 4)

    qc, kc, vc = chunks(q), chunks(k), chunks(v)
    bc = chunks(beta[..., None])[..., 0]
    gc = jnp.cumsum(chunks(g[..., None])[..., 0], axis=-1)
    idx = jnp.arange(cs)
    incl = idx[:, None] >= idx[None, :]
    strict = idx[:, None] > idx[None, :]
    diff = gc[..., :, None] - gc[..., None, :]
    decay = jnp.where(incl, jnp.exp(jnp.where(incl, diff, 0.0)), 0.0)
    kk = jnp.einsum('nbhid,nbhjd->nbhij', kc, kc)
    lower = jnp.where(strict, bc[..., :, None] * kk * decay, 0.0)
    unit_lower = lower + jnp.eye(cs, dtype=lower.dtype)
    rhs = jnp.concatenate([kc * (bc * jnp.exp(gc))[..., None], vc * bc[..., None]], axis=-1)
    sol = lax.linalg.triangular_solve(unit_lower, rhs, left_side=True, lower=True,
                                      unit_diagonal=True)
    w_k, u_v = sol[..., :dk], sol[..., dk:]
    attn = jnp.einsum('nbhid,nbhjd->nbhij', qc, kc) * decay
    q_decayed = qc * jnp.exp(gc)[..., None]
    k_tail = kc * jnp.exp(gc[..., -1:] - gc)[..., None]
    chunk_decay = jnp.exp(gc[..., -1])[..., None, None]

    def step(s, xs):
        w_i, u_i, a_i, qd_i, kt_i, cd_i = xs
        u = u_i - jnp.einsum('bhid,bhde->bhie', w_i, s)
        o = jnp.einsum('bhid,bhde->bhie', qd_i, s) + jnp.einsum('bhij,bhje->bhie', a_i, u)
        s = s * cd_i + jnp.einsum('bhid,bhie->bhde', kt_i, u)
        return s, o

    s_fin, o = lax.scan(step, s0, (w_k, u_v, attn, q_decayed, k_tail, chunk_decay))
    o = o.transpose(1, 0, 3, 2, 4).reshape(bsz, n_chunks * cs, n_heads, -1)[:, :seq_len]
    return o, s_fin


def gdn_mixer(q_in, k_in, v_in, z, b, a, conv_hist, s0, conv_w, a_log, dt_bias, norm_w):
    bsz, seq_len, _ = q_in.shape
    qkv, hist_new = causal_conv(jnp.concatenate([q_in, k_in, v_in], axis=-1), conv_hist, conv_w)
    qkv = jax.nn.silu(qkv.astype(jnp.float32))
    q, k, v = jnp.split(qkv, 3, axis=-1)
    shp = (bsz, seq_len, GDN_HEADS, GDN_HEAD_DIM)
    q = l2_normalize(q.reshape(shp)) * (GDN_HEAD_DIM ** -0.5)
    k = l2_normalize(k.reshape(shp))
    v = v.reshape(shp)
    beta = jax.nn.sigmoid(b.astype(jnp.float32))
    g = -jnp.exp(a_log.astype(jnp.float32)) * jax.nn.softplus(
        a.astype(jnp.float32) + dt_bias.astype(jnp.float32))
    o, s_new = gated_delta_rule(q, k, v, beta, g, s0.astype(jnp.float32))
    o = rms_norm(o, norm_w) * jax.nn.silu(z.reshape(shp).astype(jnp.float32))
    return o.reshape(bsz, seq_len, GDN_WIDTH).astype(q_in.dtype), hist_new, s_new.astype(s0.dtype)


def short_conv_mixer(h, c_gate, b_gate, hist, conv_w):
    y, hist_new = causal_conv(c_gate * h, hist, conv_w)
    return b_gate * y, hist_new


def moba_attention(q, k_full, v_full, q_pos0):
    bsz, q_len, n_heads, hd = q.shape
    k_len = k_full.shape[1]
    qf = q.astype(jnp.float32).transpose(0, 2, 1, 3) * (hd ** -0.5)
    kf = k_full.astype(jnp.float32)
    vf = v_full.astype(jnp.float32)
    n_blocks = max(-(-k_len // MOBA_BLOCK), MOBA_TOPK)
    tail = n_blocks * MOBA_BLOCK - k_len

    def blocks(t):
        t = jnp.pad(t, ((0, 0), (0, tail), (0, 0), (0, 0)))
        return t.reshape(bsz, n_blocks, MOBA_BLOCK, n_heads, hd).transpose(0, 3, 1, 2, 4)

    kb, vb = blocks(kf), blocks(vf)
    k_mean = jnp.mean(kb, axis=3)

    def window_src(t):
        return jnp.pad(t, ((0, 0), (MOBA_BLOCK - 1, 0), (0, 0), (0, 0))).transpose(0, 2, 1, 3)

    kw_src, vw_src = window_src(kf), window_src(vf)
    qc = MOBA_QCHUNK if q_len % MOBA_QCHUNK == 0 else q_len
    n_qc = q_len // qc
    win = MOBA_BLOCK + qc - 1
    q_chunks = qf.reshape(bsz, n_heads, n_qc, qc, hd).transpose(2, 0, 1, 3, 4)
    starts = q_pos0 + jnp.arange(n_qc, dtype=jnp.int32) * qc
    b_idx = jnp.arange(bsz)[:, None, None, None]
    h_idx = jnp.arange(n_heads)[None, :, None, None]
    blk_ids = jnp.arange(n_blocks)
    rank = jnp.arange(MOBA_TOPK)

    def one_chunk(args):
        qi, s = args
        t = s + jnp.arange(qc)
        bt = t // MOBA_BLOCK
        gate = jnp.einsum('bhqd,bhnd->bhqn', qi, k_mean)
        gate = jnp.where(blk_ids[None, :] < bt[:, None], gate, NEG_INF)
        _, sel = lax.top_k(gate, MOBA_TOPK)
        valid = rank[None, :] < bt[:, None]
        ks = kb[b_idx, h_idx, sel]
        vs = vb[b_idx, h_idx, sel]
        s_sel = jnp.einsum('bhqd,bhqnkd->bhqnk', qi, ks)
        s_sel = jnp.where(valid[:, :, None], s_sel, NEG_INF)
        s_sel = s_sel.reshape(bsz, n_heads, qc, MOBA_TOPK * MOBA_BLOCK)
        kw = lax.dynamic_slice_in_dim(kw_src, s, win, axis=2)
        vw = lax.dynamic_slice_in_dim(vw_src, s, win, axis=2)
        pos = s - (MOBA_BLOCK - 1) + jnp.arange(win)
        own = (pos[None, :] >= (bt * MOBA_BLOCK)[:, None]) & (pos[None, :] <= t[:, None])
        s_own = jnp.where(own, jnp.einsum('bhqd,bhkd->bhqk', qi, kw), NEG_INF)
        p = jax.nn.softmax(jnp.concatenate([s_sel, s_own], axis=-1), axis=-1)
        p_sel = p[..., :MOBA_TOPK * MOBA_BLOCK].reshape(bsz, n_heads, qc, MOBA_TOPK, MOBA_BLOCK)
        p_own = p[..., MOBA_TOPK * MOBA_BLOCK:]
        return (jnp.einsum('bhqnk,bhqnkd->bhqd', p_sel, vs)
                + jnp.einsum('bhqk,bhkd->bhqd', p_own, vw))

    out = lax.map(one_chunk, (q_chunks, starts))
    return out.transpose(1, 0, 3, 2, 4).reshape(bsz, q_len, n_heads, hd).astype(q.dtype)


def decoder_layer(x, gdn_s0, gdn_hist, sc_hist, k_past, v_past,
                  n_ffn1, ffn1_w_gate, ffn1_w_up, ffn1_w_down, n_mix, w_in,
                  gdn_conv_w, gdn_a_log, gdn_dt_bias, gdn_norm_w, sc_conv_w, w_out,
                  n_ffn2, ffn2_w_gate, ffn2_w_up, ffn2_w_down):
    bsz, seq_len, _ = x.shape
    x = x + 0.5 * swiglu(rms_norm(x, n_ffn1), ffn1_w_gate, ffn1_w_up, ffn1_w_down)
    h = rms_norm(x, n_mix) @ w_in
    q_a, k_a, v_a, z_a, b_a, a_a, h_b, c_b, g_b, q_c, k_c, v_c = split_projection(h)
    o_a, gdn_hist_new, gdn_s_new = gdn_mixer(q_a, k_a, v_a, z_a, b_a, a_a, gdn_hist, gdn_s0,
                                             gdn_conv_w, gdn_a_log, gdn_dt_bias, gdn_norm_w)
    o_b, sc_hist_new = short_conv_mixer(h_b, c_b, g_b, sc_hist, sc_conv_w)
    mshp = (bsz, seq_len, MOBA_HEADS, MOBA_HEAD_DIM)
    q_c, k_c, v_c = q_c.reshape(mshp), k_c.reshape(mshp), v_c.reshape(mshp)
    k_full = jnp.concatenate([k_past.astype(x.dtype), k_c], axis=1)
    v_full = jnp.concatenate([v_past.astype(x.dtype), v_c], axis=1)
    o_c = moba_attention(q_c, k_full, v_full, k_past.shape[1]).reshape(bsz, seq_len, MOBA_WIDTH)
    x = x + jnp.concatenate([o_a, o_b, o_c], axis=-1) @ w_out
    x = x + 0.5 * swiglu(rms_norm(x, n_ffn2), ffn2_w_gate, ffn2_w_up, ffn2_w_down)
    return x, gdn_s_new, gdn_hist_new, sc_hist_new, k_c, v_c


def trunk(x, layer_states, layer_params):
    new_states = []
    for l in range(DEPTH):
        out = decoder_layer(x, *layer_states[l], *[p[l] for p in layer_params])
        x = out[0]
        new_states.append(out[1:])
    stacked = [jnp.stack([st[i] for st in new_states]) for i in range(5)]
    return x, stacked


def setup_inputs(seed: int = 0) -> dict:
    key = jax.random.key(seed)
    ks = jax.random.split(key, 32)
    n_pages = PAST_LEN // PAGE_SIZE
    n_pool = (5 * DEC_BATCH * n_pages) // 4

    def nrm(k, shape, scale):
        return jax.random.normal(k, shape, jnp.float32) * scale

    def gain(k, shape):
        return 1.0 + 0.01 * jax.random.normal(k, shape, jnp.float32)

    dt = jnp.exp(jax.random.uniform(ks[14], (DEPTH, GDN_HEADS), jnp.float32,
                                    minval=math.log(1e-3), maxval=math.log(1e-1)))
    page_table = jax.random.permutation(ks[7], n_pool)[:DEC_BATCH * n_pages]
    page_table = page_table.reshape(DEC_BATCH, n_pages).astype(jnp.int32)
    return {
        'x_prompt': nrm(ks[0], (BATCH, SEQ, D_MODEL), 1.0),
        'x_sample': nrm(ks[1], (DEC_BATCH, DEC_SEQ, D_MODEL), 1.0),
        'state_gdn': nrm(ks[2], (DEPTH, DEC_BATCH, GDN_HEADS, GDN_HEAD_DIM, GDN_HEAD_DIM),
                         GDN_HEAD_DIM ** -0.5),
        'state_gdn_conv': nrm(ks[3], (DEPTH, DEC_BATCH, GDN_CONV - 1, 3 * GDN_WIDTH), 1.0),
        'state_sconv': nrm(ks[4], (DEPTH, DEC_BATCH, SC_CONV - 1, SC_WIDTH), 1.0),
        'cache_k': nrm(ks[5], (DEPTH, n_pool, PAGE_SIZE, MOBA_HEADS, MOBA_HEAD_DIM), 1.0),
        'cache_v': nrm(ks[6], (DEPTH, n_pool, PAGE_SIZE, MOBA_HEADS, MOBA_HEAD_DIM), 1.0),
        'page_table': page_table,
        'norm_ffn1': gain(ks[8], (DEPTH, D_MODEL)),
        'ffn1_w_gate': nrm(ks[9], (DEPTH, D_MODEL, D_FF), D_MODEL ** -0.5),
        'ffn1_w_up': nrm(ks[10], (DEPTH, D_MODEL, D_FF), D_MODEL ** -0.5),
        'ffn1_w_down': nrm(ks[11], (DEPTH, D_FF, D_MODEL), D_FF ** -0.5),
        'norm_mix': gain(ks[12], (DEPTH, D_MODEL)),
        'w_in': nrm(ks[13], (DEPTH, D_MODEL, PROJ_WIDTH), D_MODEL ** -0.5),
        'gdn_conv_w': nrm(ks[15], (DEPTH, GDN_CONV, 3 * GDN_WIDTH), GDN_CONV ** -0.5),
        'gdn_a_log': jnp.log(jax.random.uniform(ks[16], (DEPTH, GDN_HEADS), jnp.float32,
                                                minval=1.0, maxval=16.0)),
        'gdn_dt_bias': dt + jnp.log(-jnp.expm1(-dt)),
        'gdn_norm_w': gain(ks[17], (DEPTH, GDN_HEAD_DIM)),
        'sc_conv_w': nrm(ks[18], (DEPTH, SC_CONV, SC_WIDTH), SC_CONV ** -0.5),
        'w_out': nrm(ks[19], (DEPTH, MIX_WIDTH, D_MODEL), MIX_WIDTH ** -0.5),
        'norm_ffn2': gain(ks[20], (DEPTH, D_MODEL)),
        'ffn2_w_gate': nrm(ks[21], (DEPTH, D_MODEL, D_FF), D_MODEL ** -0.5),
        'ffn2_w_up': nrm(ks[22], (DEPTH, D_MODEL, D_FF), D_MODEL ** -0.5),
        'ffn2_w_down': nrm(ks[23], (DEPTH, D_FF, D_MODEL), D_FF ** -0.5),
        'norm_final': gain(ks[24], (D_MODEL,)),
    }


def reference(x_prompt, x_sample, state_gdn, state_gdn_conv, state_sconv, cache_k, cache_v,
              page_table, norm_ffn1, ffn1_w_gate, ffn1_w_up, ffn1_w_down, norm_mix, w_in,
              gdn_conv_w, gdn_a_log, gdn_dt_bias, gdn_norm_w, sc_conv_w, w_out,
              norm_ffn2, ffn2_w_gate, ffn2_w_up, ffn2_w_down, norm_final):
    layer_params = (norm_ffn1, ffn1_w_gate, ffn1_w_up, ffn1_w_down, norm_mix, w_in,
                    gdn_conv_w, gdn_a_log, gdn_dt_bias, gdn_norm_w, sc_conv_w, w_out,
                    norm_ffn2, ffn2_w_gate, ffn2_w_up, ffn2_w_down)
    pb = x_prompt.shape[0]
    pdt = x_prompt.dtype
    prompt_states = [(jnp.zeros((pb, GDN_HEADS, GDN_HEAD_DIM, GDN_HEAD_DIM), pdt),
                      jnp.zeros((pb, GDN_CONV - 1, 3 * GDN_WIDTH), pdt),
                      jnp.zeros((pb, SC_CONV - 1, SC_WIDTH), pdt),
                      jnp.zeros((pb, 0, MOBA_HEADS, MOBA_HEAD_DIM), pdt),
                      jnp.zeros((pb, 0, MOBA_HEADS, MOBA_HEAD_DIM), pdt)) for _ in range(DEPTH)]
    db, n_seq_pages = page_table.shape
    past_shape = (db, n_seq_pages * PAGE_SIZE, MOBA_HEADS, MOBA_HEAD_DIM)
    sample_states = [(state_gdn[l], state_gdn_conv[l], state_sconv[l],
                      cache_k[l][page_table].reshape(past_shape),
                      cache_v[l][page_table].reshape(past_shape)) for l in range(DEPTH)]
    h_p, (p_gdn, p_conv, p_sconv, p_k, p_v) = trunk(x_prompt, prompt_states, layer_params)
    h_s, (s_gdn, s_conv, s_sconv, s_k, s_v) = trunk(x_sample, sample_states, layer_params)
    y_prompt = rms_norm(h_p, norm_final)
    y_sample = rms_norm(h_s, norm_final)
    return (y_prompt, y_sample, p_gdn, p_conv, p_sconv, p_k, p_v,
            s_gdn, s_conv, s_sconv, s_k, s_v)
```

```cpp
#include <hip/hip_runtime.h>
#include <cstdio>
#include <cstdint>

#ifndef MK_ONE_LAUNCH
#define MK_ONE_LAUNCH 1
#define HREPS 1,1,1,1,1
#endif

#define LAS __attribute__((address_space(3)))
#define GAS __attribute__((address_space(1)))
typedef unsigned short bf16_t;
typedef short bf16x8 __attribute__((ext_vector_type(8)));
typedef short s16x4 __attribute__((ext_vector_type(4)));
typedef float f32x4 __attribute__((ext_vector_type(4)));
typedef float f32x2 __attribute__((ext_vector_type(2)));
typedef unsigned u32x4 __attribute__((ext_vector_type(4)));
typedef unsigned u32x2 __attribute__((ext_vector_type(2)));

constexpr int DM = 1024, MP = 16384, MS = 512, MT = MP + MS, SEQ = 2048;
constexpr int FF = 2816, NGU = 2 * FF, NIN = 3584, PROJ = 3592;
constexpr int NPOOL = 2560, NPAGES = 16;
constexpr float EPS = 1e-6f;
constexpr size_t O_YP = 0, O_YS = 16777216, O_PGDN = 17301504, O_PCONV = 18350080, O_PSCONV = 18423808, O_PK = 18432000, O_PV = 26820608,
                 O_SGDN = 35209216, O_SCONV = 51986432, O_SSCONV = 53166080, O_SK = 53297152, O_SV = 53559296, O_END = 53821440;
constexpr size_t MiB = 1u << 20;
constexpr size_t WS_CTL = 0, CTL_ZERO_BYTES = 65536;
constexpr size_t WS_W = 1 * MiB, W_LAYER = 42 * MiB;
constexpr size_t WO_GU1 = 0, WO_DN1 = 11 * MiB, WO_IN = 16 * MiB + MiB / 2, WO_OUT = 23 * MiB + MiB / 2, WO_GU2 = 25 * MiB + MiB / 2, WO_DN2 = 36 * MiB + MiB / 2;
constexpr size_t WS_WBA = 85 * MiB, WS_XRES = 86 * MiB, WS_XB = 152 * MiB, WS_SSQ = 185 * MiB, WS_HID = 187 * MiB, WS_GQKV = 278 * MiB, WS_GZ = 328 * MiB,
                 WS_SC = 345 * MiB, WS_MQ = 370 * MiB, WS_MK = 379 * MiB, WS_MV = 388 * MiB, WS_BA = 397 * MiB, WS_MIX = 398 * MiB, WS_KM = 431 * MiB,
                 WS_GW = 432 * MiB, WS_GU = 448 * MiB, WS_GATT = 480 * MiB, WS_GQD = 488 * MiB, WS_GAP = 504 * MiB, WS_GBC = 536 * MiB, WS_GCD = 600 * MiB,
                 WS_GST = 601 * MiB, WS_END = 633 * MiB;
constexpr int CW_BAR = 4096;
constexpr int LDS_BYTES = 163840, MISC_OFF = 163840 - 512;

__device__ __forceinline__ float bf2f(unsigned b) { return __uint_as_float(b << 16); }
__device__ __forceinline__ unsigned f2bf(float f) { unsigned u = __float_as_uint(f); return (u + 0x7fffu + ((u >> 16) & 1u)) >> 16; }
typedef __bf16 bf16x2_t __attribute__((ext_vector_type(2)));
__device__ __forceinline__ unsigned pk2(float lo, float hi) { const f32x2 v = {lo, hi}; return __builtin_bit_cast(unsigned, __builtin_convertvector(v, bf16x2_t)); }
__device__ __forceinline__ float wave_sum(float v) {
#pragma unroll
    for (int o = 1; o < 64; o <<= 1) v += __shfl_xor(v, o);
    return v;
}
__device__ __forceinline__ float wave_max(float v) {
#pragma unroll
    for (int o = 1; o < 64; o <<= 1) v = fmaxf(v, __shfl_xor(v, o));
    return v;
}
__device__ __forceinline__ float silu_f(float x) { return x * __builtin_amdgcn_rcpf(1.0f + __expf(-x)); }
#define LDS_BARRIER() do { asm volatile("s_waitcnt lgkmcnt(0)" ::: "memory"); __builtin_amdgcn_s_barrier(); asm volatile("" ::: "memory"); } while (0)
namespace pg8 {
#define PG8_LAS __attribute__((address_space(3)))
typedef unsigned short bf16_t;
typedef short bf16x8 __attribute__((ext_vector_type(8)));
typedef float f32x4 __attribute__((ext_vector_type(4)));
typedef unsigned u32x4 __attribute__((ext_vector_type(4)));
constexpr int BM = 256, BK = 64, HALF = 128, HTB = HALF * BK * 2  , STAGE_BYTES = 8 * HTB, NXCD = 8, WGM = 8;

__host__ __device__ __forceinline__ int lds_byte(int r, int c) { const int st = (r >> 4) * 2 + (c >> 5), rr = r & 15, cc = c & 31, ob = rr * 64 + cc * 2; return st * 1024 + (ob ^ (((ob >> 9) & 1) << 5)); }
__host__ __device__ __forceinline__ void stage_rc(int b, int& R, int& C) { const int st = b / 1024, sb = b % 1024, swz = sb ^ (((sb >> 9) & 1) << 5); R = (st >> 1) * 16 + swz / 64; C = (st & 1) * 32 + (swz % 64) / 2; }
__host__ __device__ __forceinline__ int perm32(int rho) { const int n = rho >> 4, i = rho & 15; return 8 * (i >> 2) + 4 * n + (i & 3); }

struct Unit { int pm, pn; };
struct Gemm { const bf16_t* A; const bf16_t* Bt; int M, N, K; };

struct StaticOrder {
    int nM, nN, nwg, G, c;
    __host__ __device__ void init(int M, int N, int G_, int c_) { nM = M / BM; nN = N / BM; nwg = nM * nN; G = G_; c = c_; }
    __host__ __device__ bool next(int i, Unit& u) const {
        const long L = (long)i * G + c; if (L >= nwg) return false;
        int wgid = (int)L; { const int q = nwg / NXCD, r = nwg % NXCD, xcd = wgid % NXCD, off = wgid / NXCD; wgid = (xcd < r ? xcd * (q + 1) : r * (q + 1) + (xcd - r) * q) + off; }
        const int nig = WGM * nN, gid = wgid / nig, fm = gid * WGM, gsz = (nM - fm) < WGM ? (nM - fm) : WGM;
        u.pm = fm + ((wgid % nig) % gsz); u.pn = (wgid % nig) / gsz; return true;
    }
    __device__ __forceinline__ void a_ready(const Unit&) const {}
    __device__ __forceinline__ void done(const Unit&) const {}
};

__device__ __forceinline__ unsigned cvt_pk_bf16(float lo, float hi) { return pk2(lo, hi); }
typedef float f32x2 __attribute__((ext_vector_type(2)));
template <class Epi, class Sched, bool ALIGN_EPI = false, bool SP2 = false>
__device__ __forceinline__ void gemm_phase(PG8_LAS unsigned char* lds, const Gemm g, const Sched& S, const Epi& E, const int tid_in) {
    const int tid = tid_in, wid = __builtin_amdgcn_readfirstlane(tid >> 6), lane = tid & 63, wr = wid >> 2, wc = wid & 3, fr = lane & 15, fq = lane >> 4;
    const int K = g.K, nt = K / BK;
    unsigned voffA[2], voffB[2];
#pragma unroll
    for (int i = 0; i < 2; ++i) { int R, C; stage_rc(tid * 16 + i * 8192, R, C); const int Rb = Epi::PERM ? ((R & ~31) + perm32(R & 31)) : R;
        voffA[i] = (unsigned)(R * K + C) * 2u; voffB[i] = (unsigned)(Rb * K + C) * 2u; }
    const size_t kstep = (size_t)(BK * 2);
    const size_t hstep = (size_t)HALF * K * 2;
    const size_t tstep = 2 * hstep;
    const unsigned ldsw = (unsigned)wid * 1024u;
    const int aoff = lds_byte(wr * 64 + fr, fq * 8), boff = lds_byte(wc * 32 + fr, fq * 8);
#define PG8_SA(b, h) (((b) * 2 + (h)) * HTB)
#define PG8_SB(b, h) ((4 + (b) * 2 + (h)) * HTB)
#define PG8_STAGE(bufoff, gbase, voff) do { _Pragma("unroll") for (int _i = 0; _i < 2; ++_i) \
        __builtin_amdgcn_global_load_lds((const unsigned*)((const char*)(gbase) + (voff)[_i]), (PG8_LAS unsigned*)(lds + (bufoff) + ldsw + _i * 8192), 16, 0, 0); } while (0)
#define PG8_LDA(dst, b, h) do { _Pragma("unroll") for (int m = 0; m < 4; ++m) _Pragma("unroll") for (int k = 0; k < 2; ++k) dst[m][k] = *(const PG8_LAS bf16x8*)(lds + PG8_SA(b, h) + aoff + m * 2048 + k * 1024); } while (0)
#define PG8_LDB(dst, b, h) do { _Pragma("unroll") for (int n = 0; n < 2; ++n) _Pragma("unroll") for (int k = 0; k < 2; ++k) dst[n][k] = *(const PG8_LAS bf16x8*)(lds + PG8_SB(b, h) + boff + n * 2048 + k * 1024); } while (0)
#define PG8_MMA(ai, bj, At, Bt) do { __builtin_amdgcn_s_setprio(1); _Pragma("unroll") for (int m = 0; m < 4; ++m) _Pragma("unroll") for (int n = 0; n < 2; ++n) _Pragma("unroll") for (int k = 0; k < 2; ++k) \
        acc[ai][bj][m][n] = __builtin_amdgcn_mfma_f32_16x16x32_bf16(Bt[n][k], At[m][k], acc[ai][bj][m][n], 0, 0, 0); __builtin_amdgcn_s_setprio(0); } while (0)
#define PG8_WAIT_V(n) asm volatile("s_waitcnt vmcnt(" #n ")" ::: "memory")
#define PG8_WAIT_L(n) asm volatile("s_waitcnt lgkmcnt(" #n ")" ::: "memory")
#define PG8_BAR __builtin_amdgcn_s_barrier()
#define PG8_SCHED __builtin_amdgcn_sched_barrier(0)
    Unit cur, nxt; int ui = 0;
    if (!S.next(0, cur)) return;
    f32x4 acc[2][2][4][2];
#pragma unroll
    for (int a = 0; a < 2; ++a)
#pragma unroll
        for (int b = 0; b < 2; ++b)
#pragma unroll
            for (int m = 0; m < 4; ++m)
#pragma unroll
                for (int n = 0; n < 2; ++n) acc[a][b][m][n] = (f32x4){0.f, 0.f, 0.f, 0.f};
    bf16x8 At[4][2], B0[2][2], B1[2][2];
    const char* cA = (const char*)g.A + (size_t)cur.pm * tstep; const char* cB = (const char*)g.Bt + (size_t)cur.pn * tstep;
    S.a_ready(cur);
    if constexpr (SP2) {
        PG8_STAGE(PG8_SB(0, 0), cB, voffB); PG8_STAGE(PG8_SB(0, 1), cB + hstep, voffB); PG8_STAGE(PG8_SA(0, 0), cA, voffA); PG8_STAGE(PG8_SA(0, 1), cA + hstep, voffA);
        if (wr == 1) PG8_BAR;
        PG8_WAIT_V(2); PG8_BAR;
        PG8_STAGE(PG8_SB(1, 0), cB + kstep, voffB); PG8_STAGE(PG8_SA(1, 0), cA + kstep, voffA); PG8_STAGE(PG8_SB(1, 1), cB + hstep + kstep, voffB);
        PG8_WAIT_V(6); PG8_BAR;
    } else {
        PG8_STAGE(PG8_SB(0, 0), cB, voffB); PG8_STAGE(PG8_SA(0, 0), cA, voffA); PG8_STAGE(PG8_SB(0, 1), cB + hstep, voffB); PG8_STAGE(PG8_SA(0, 1), cA + hstep, voffA);
        if (wr == 1) PG8_BAR;
        PG8_WAIT_V(4); PG8_BAR;
        PG8_STAGE(PG8_SB(1, 0), cB + kstep, voffB); PG8_STAGE(PG8_SA(1, 0), cA + kstep, voffA); PG8_STAGE(PG8_SB(1, 1), cB + hstep + kstep, voffB);
        PG8_WAIT_V(6); PG8_BAR;
    }
    for (;;) {
        const bool has_next = S.next(ui + 1, nxt);
        const char* nA = has_next ? (const char*)g.A + (size_t)nxt.pm * tstep : cA; const char* nB = has_next ? (const char*)g.Bt + (size_t)nxt.pn * tstep : cB;
        for (int t = 0; t < nt; t += 2) {
            const bool last = (t == nt - 2);
            const char* a1 = cA + (size_t)(t + 1) * kstep;
            const char* a2 = last ? nA : cA + (size_t)(t + 2) * kstep; const char* b2 = last ? nB : cB + (size_t)(t + 2) * kstep;
            const char* a3 = a2 + kstep; const char* b3 = b2 + kstep;
            if (last && has_next) S.a_ready(nxt);
            if constexpr (SP2) {
            PG8_LDB(B0, 0, 0); PG8_LDB(B1, 0, 1); PG8_SCHED; PG8_LDA(At, 0, 0); PG8_STAGE(PG8_SA(1, 1), a1 + hstep, voffA);
            PG8_WAIT_V(8); PG8_WAIT_L(0); PG8_BAR; PG8_MMA(0, 0, At, B0); PG8_MMA(0, 1, At, B1); PG8_BAR; PG8_SCHED;
            PG8_LDA(At, 0, 1); PG8_STAGE(PG8_SB(0, 0), b2, voffB); PG8_STAGE(PG8_SB(0, 1), b2 + hstep, voffB); PG8_STAGE(PG8_SA(0, 0), a2, voffA);
            PG8_WAIT_V(8); PG8_WAIT_L(0); PG8_BAR; PG8_MMA(1, 0, At, B0); PG8_MMA(1, 1, At, B1); PG8_BAR; PG8_SCHED;
            PG8_LDB(B0, 1, 0); PG8_LDB(B1, 1, 1); PG8_SCHED; PG8_LDA(At, 1, 0); PG8_STAGE(PG8_SA(0, 1), a2 + hstep, voffA);
            PG8_WAIT_V(8); PG8_WAIT_L(0); PG8_BAR; PG8_MMA(0, 0, At, B0); PG8_MMA(0, 1, At, B1); PG8_BAR; PG8_SCHED;
            PG8_LDA(At, 1, 1); PG8_STAGE(PG8_SB(1, 0), b3, voffB); PG8_STAGE(PG8_SB(1, 1), b3 + hstep, voffB); PG8_STAGE(PG8_SA(1, 0), a3, voffA);
            PG8_WAIT_V(8); PG8_WAIT_L(0); PG8_BAR; PG8_MMA(1, 0, At, B0); PG8_MMA(1, 1, At, B1); PG8_BAR; PG8_SCHED;
            } else {
            PG8_LDB(B0, 0, 0); PG8_SCHED; PG8_LDA(At, 0, 0); PG8_STAGE(PG8_SA(1, 1), a1 + hstep, voffA);
            PG8_WAIT_L(8); PG8_BAR; PG8_WAIT_L(0); PG8_MMA(0, 0, At, B0); PG8_BAR; PG8_SCHED;
            PG8_LDB(B1, 0, 1); PG8_STAGE(PG8_SB(0, 0), b2, voffB);
            PG8_BAR; PG8_WAIT_L(0); PG8_MMA(0, 1, At, B1); PG8_BAR;
            PG8_LDA(At, 0, 1); PG8_STAGE(PG8_SA(0, 0), a2, voffA);
            PG8_BAR; PG8_WAIT_L(0); PG8_MMA(1, 0, At, B0); PG8_BAR; PG8_SCHED;
            PG8_STAGE(PG8_SB(0, 1), b2 + hstep, voffB);
            PG8_WAIT_V(6); PG8_BAR; PG8_MMA(1, 1, At, B1); PG8_BAR;
            PG8_LDB(B0, 1, 0); PG8_SCHED; PG8_LDA(At, 1, 0); PG8_STAGE(PG8_SA(0, 1), a2 + hstep, voffA);
            PG8_WAIT_L(8); PG8_BAR; PG8_WAIT_L(0); PG8_MMA(0, 0, At, B0); PG8_BAR; PG8_SCHED;
            PG8_LDB(B1, 1, 1); PG8_STAGE(PG8_SB(1, 0), b3, voffB);
            PG8_BAR; PG8_WAIT_L(0); PG8_MMA(0, 1, At, B1); PG8_BAR;
            PG8_LDA(At, 1, 1); PG8_STAGE(PG8_SA(1, 0), a3, voffA);
            PG8_BAR; PG8_WAIT_L(0); PG8_MMA(1, 0, At, B0); PG8_BAR; PG8_SCHED;
            PG8_STAGE(PG8_SB(1, 1), b3 + hstep, voffB);
            PG8_WAIT_V(6); PG8_BAR; PG8_MMA(1, 1, At, B1); PG8_BAR;
            }
        }
        if constexpr (ALIGN_EPI) { if (wr == 0) PG8_BAR; }
        if constexpr (!Epi::AFTER_DRAIN) { E(acc, cur, wr, wc, fr, fq, ui); S.done(cur); }
        if (!has_next) break;
#pragma unroll
        for (int a = 0; a < 2; ++a)
#pragma unroll
            for (int b = 0; b < 2; ++b)
#pragma unroll
                for (int m = 0; m < 4; ++m)
#pragma unroll
                    for (int n = 0; n < 2; ++n) acc[a][b][m][n] = (f32x4){0.f, 0.f, 0.f, 0.f};
        cur = nxt; cA = nA; cB = nB; ++ui;
        if constexpr (ALIGN_EPI) { if (wr == 1) PG8_BAR; }
    }
    PG8_WAIT_V(0);
    if constexpr (!ALIGN_EPI) { if (wr == 0) PG8_BAR; }
    PG8_BAR;
    if constexpr (Epi::AFTER_DRAIN) { E.fused(acc, cur, wr, wc, fr, fq, lds, wid, lane); S.done(cur); }
#undef PG8_SA
#undef PG8_SB
#undef PG8_STAGE
#undef PG8_LDA
#undef PG8_LDB
#undef PG8_MMA
#undef PG8_WAIT_V
#undef PG8_WAIT_L
#undef PG8_BAR
#undef PG8_SCHED
}
}
#define XB_TMO      128
#define XB_XCNT(j)  (256  + 64 * (j))
#define XB_XSUB(j)  (1280 + 64 * (j))
#define XB_XGEN(j)  (2304 + 64 * (j))
#define XB_TOP      3328
#define XB_TOPGEN   3392
#define XCD_BAR_WORDS 3456
#define XB_SPIN_CAP (1u << 18)

__device__ __forceinline__ unsigned xb_ld(unsigned* p)              { return __hip_atomic_load(p, __ATOMIC_RELAXED, __HIP_MEMORY_SCOPE_AGENT); }
__device__ __forceinline__ unsigned xb_add(unsigned* p, unsigned v) { return __hip_atomic_fetch_add(p, v, __ATOMIC_RELAXED, __HIP_MEMORY_SCOPE_AGENT); }
__device__ __forceinline__ unsigned xb_xcc_id() { return (unsigned)__builtin_amdgcn_s_getreg((3 << 11) | 20) & 0xFu; }
#define XB_SPIN(cond, bar) do { unsigned _sp = 0; while (cond) { __builtin_amdgcn_s_sleep(1); \
    if ((++_sp & 255u) == 0u) { if (xb_ld(&(bar)[XB_TMO])) break; if (_sp > XB_SPIN_CAP) { atomicAdd(&(bar)[XB_TMO], 1u); break; } } } } while (0)

struct XcdBarrier {
    unsigned* bar; unsigned x;
    volatile LAS unsigned* st;
};

__device__ __forceinline__ XcdBarrier xcd_barrier_post(unsigned* bar, volatile LAS unsigned* st) {
    XcdBarrier b; b.bar = bar; b.x = xb_xcc_id(); b.st = st;
    if (threadIdx.x == 0) (void)xb_add(&bar[XB_XCNT(b.x)], 1u);
    return b;
}
__device__ __forceinline__ void xcd_barrier_complete(unsigned* bar, unsigned x, unsigned& nloc, unsigned& nx) {
    const unsigned G = gridDim.x * gridDim.y * gridDim.z;
    unsigned sum, cnt, mine, sp = 0u;
    for (;;) {
        sum = 0u; cnt = 0u; mine = 0u;
#pragma unroll
        for (unsigned j = 0; j < 16; ++j) { const unsigned c = xb_ld(&bar[XB_XCNT(j)]); sum += c; cnt += (c > 0u) ? 1u : 0u; mine = (j == x) ? c : mine; }
        if (sum == G) break;
        __builtin_amdgcn_s_sleep(1);
        if ((++sp & 255u) == 0u) { if (xb_ld(&bar[XB_TMO])) break; if (sp > XB_SPIN_CAP) { atomicAdd(&bar[XB_TMO], 1u); break; } }
    }
    nloc = mine > 0u ? mine : 1u; nx = cnt > 0u ? cnt : 1u;
}

__device__ __forceinline__ void xcd_barrier(const XcdBarrier& b) {
    asm volatile("s_waitcnt vmcnt(0)" ::: "memory");
    __syncthreads();
    if (threadIdx.x == 0) {
        unsigned* bar = b.bar;
        __builtin_amdgcn_s_waitcnt(0);
        unsigned nloc = b.st[0], nx = b.st[1];
        if (nloc == 0u) { xcd_barrier_complete(bar, b.x, nloc, nx); b.st[0] = nloc; b.st[1] = nx; }
        const unsigned old = xb_add(&bar[XB_XSUB(b.x)], 1u);
        const unsigned gen = old / nloc;
        if (old + 1u == (gen + 1u) * nloc) {
            __builtin_amdgcn_fence(__ATOMIC_RELEASE, "agent");
            asm volatile("s_waitcnt vmcnt(0)" ::: "memory");
            const unsigned og = xb_add(&bar[XB_TOP], 1u);
            const unsigned tg = og / nx;
            if (og + 1u == (tg + 1u) * nx) xb_add(&bar[XB_TOPGEN], 1u);
            else XB_SPIN(xb_ld(&bar[XB_TOPGEN]) == tg, bar);
            __builtin_amdgcn_fence(__ATOMIC_ACQUIRE, "agent");
            xb_add(&bar[XB_XGEN(b.x)], 1u);
            asm volatile("s_waitcnt vmcnt(0)" ::: "memory");
        } else {
            XB_SPIN(xb_ld(&bar[XB_XGEN(b.x)]) == gen, bar);
            __builtin_amdgcn_fence(__ATOMIC_ACQUIRE, "agent");
            asm volatile("s_waitcnt vmcnt(0)" ::: "memory");
        }
    }
    __syncthreads();
}

namespace pg8 {
__device__ __forceinline__ float row_rstd(const float* ssq, int row) {
    const f32x4* p = (const f32x4*)(ssq + (size_t)row * 16);
    const f32x4 a = p[0], b = p[1], c = p[2], d = p[3];
    const float s = ((a[0] + a[1]) + (a[2] + a[3])) + ((b[0] + b[1]) + (b[2] + b[3])) + ((c[0] + c[1]) + (c[2] + c[3])) + ((d[0] + d[1]) + (d[2] + d[3]));
    return __builtin_amdgcn_rsqf(s * (1.0f / 1024.0f) + EPS);
}
struct EpiGU {
    static constexpr bool PERM = true, AFTER_DRAIN = false;
    const LAS float* rtab; bf16_t* hid;
    __device__ __forceinline__ void operator()(const f32x4 (&acc)[2][2][4][2], const Unit& u, int wr, int wc, int fr, int fq, int ui) const {
        asm volatile("" : "+v"(fr), "+v"(fq));
        const int col0 = u.pn * 128 + wc * 32 + 8 * fq;
#pragma unroll
        for (int ai = 0; ai < 2; ++ai)
#pragma unroll
            for (int m = 0; m < 4; ++m) {
                const int row = u.pm * BM + ai * HALF + wr * 64 + m * 16 + fr;
                const float rs = rtab[ui * 256 + ai * HALF + wr * 64 + m * 16 + fr];
                float hv[8];
#pragma unroll
                for (int n = 0; n < 2; ++n)
#pragma unroll
                    for (int i = 0; i < 4; ++i) { const float g = acc[ai][0][m][n][i] * rs, uu = acc[ai][1][m][n][i] * rs; hv[4 * n + i] = silu_f(g) * uu; }
                u32x4 w; w.x = cvt_pk_bf16(hv[0], hv[1]); w.y = cvt_pk_bf16(hv[2], hv[3]); w.z = cvt_pk_bf16(hv[4], hv[5]); w.w = cvt_pk_bf16(hv[6], hv[7]);
                *(u32x4*)(hid + (size_t)row * FF + col0) = w;
            }
    }
};
struct EpiNull {
    static constexpr bool PERM = true, AFTER_DRAIN = false;
    float* sink;
    __device__ __forceinline__ void operator()(const f32x4 (&acc)[2][2][4][2], const Unit& u, int wr, int wc, int fr, int fq, int ui) const {
        float s = 0.f;
#pragma unroll
        for (int ai = 0; ai < 2; ++ai)
#pragma unroll
            for (int bj = 0; bj < 2; ++bj)
#pragma unroll
                for (int m = 0; m < 4; ++m)
#pragma unroll
                    for (int n = 0; n < 2; ++n) s += acc[ai][bj][m][n][0] + acc[ai][bj][m][n][1] + acc[ai][bj][m][n][2] + acc[ai][bj][m][n][3];
        if (s == 1.2345678e33f) sink[0] = s;
    }
};
struct EpiRES {
    static constexpr bool PERM = true, AFTER_DRAIN = false;
    float* xres; bf16_t* xb; float* ssq; float scale;
    __device__ __forceinline__ void operator()(const f32x4 (&acc)[2][2][4][2], const Unit& u, int wr, int wc, int fr, int fq, int ui) const {
        asm volatile("" : "+v"(fr), "+v"(fq));
#pragma unroll
        for (int ai = 0; ai < 2; ++ai)
#pragma unroll
            for (int m = 0; m < 4; ++m) {
                const int row = u.pm * BM + ai * HALF + wr * 64 + m * 16 + fr;
                float ss = 0.f;
#pragma unroll
                for (int bj = 0; bj < 2; ++bj) {
                    const int col = u.pn * BM + bj * HALF + wc * 32 + 8 * fq;
                    bf16_t* xp = xb + (size_t)row * DM + col;
                    const u32x4 xo = *(const u32x4*)xp;
                    f32x4 x0 = {bf2f(xo.x & 0xffffu), bf2f(xo.x >> 16), bf2f(xo.y & 0xffffu), bf2f(xo.y >> 16)}, x1 = {bf2f(xo.z & 0xffffu), bf2f(xo.z >> 16), bf2f(xo.w & 0xffffu), bf2f(xo.w >> 16)};
                    x0 = x0 + acc[ai][bj][m][0] * scale; x1 = x1 + acc[ai][bj][m][1] * scale;
                    u32x4 w; w.x = cvt_pk_bf16(x0[0], x0[1]); w.y = cvt_pk_bf16(x0[2], x0[3]); w.z = cvt_pk_bf16(x1[0], x1[1]); w.w = cvt_pk_bf16(x1[2], x1[3]);
                    *(u32x4*)xp = w;
                    ss += (x0[0] * x0[0] + x0[1] * x0[1]) + (x0[2] * x0[2] + x0[3] * x0[3]) + (x1[0] * x1[0] + x1[1] * x1[1]) + (x1[2] * x1[2] + x1[3] * x1[3]);
                }
                ss += __shfl_xor(ss, 16); ss += __shfl_xor(ss, 32);
                if (fq == 0) ssq[(size_t)row * 16 + 4 * u.pn + wc] = ss;
            }
    }
};
struct EpiIN {
    static constexpr bool PERM = true, AFTER_DRAIN = false;
    unsigned char* ws; float* out; int layer; const LAS float* rtab;
    __device__ __forceinline__ void operator()(const f32x4 (&acc)[2][2][4][2], const Unit& u, int wr, int wc, int fr, int fq, int ui) const {
        asm volatile("" : "+v"(fr), "+v"(fq));
        const int pn = u.pn;
#pragma unroll
        for (int ai = 0; ai < 2; ++ai) {
#pragma unroll
            for (int m = 0; m < 4; ++m) {
                const int row = u.pm * BM + ai * HALF + wr * 64 + m * 16 + fr;
                const float rs = rtab[ui * 256 + ai * HALF + wr * 64 + m * 16 + fr];
                const bool samp = row >= MP;
                const int sr = row - MP;
                const int b = samp ? (sr >> 2) : (row >> 11), t = samp ? (sr & 3) : (row & 2047);
#pragma unroll
                for (int bj = 0; bj < 2; ++bj) {
                    const int cc = bj * HALF + wc * 32 + 8 * fq;
                    f32x4 v0 = acc[ai][bj][m][0] * rs, v1 = acc[ai][bj][m][1] * rs;
                    if (pn == 11) { v0 = v0 * 0.125f; v1 = v1 * 0.125f; }
                    u32x4 w; w.x = cvt_pk_bf16(v0[0], v0[1]); w.y = cvt_pk_bf16(v0[2], v0[3]); w.z = cvt_pk_bf16(v1[0], v1[1]); w.w = cvt_pk_bf16(v1[2], v1[3]);
                    if (pn < 6) {
                        const int col = pn * 256 + cc;
                        *(u32x4*)((bf16_t*)(ws + WS_GQKV) + (size_t)row * 1536 + col) = w;
                        const int j = samp ? (t - 1) : (t - 2045);
                        if (j >= 0) {
                            float* o = out + (samp ? (O_SCONV + ((size_t)(layer * 128 + b) * 3 + j) * 1536) : (O_PCONV + ((size_t)(layer * 8 + b) * 3 + j) * 1536)) + col;
                            *(f32x4*)o = v0; *(f32x4*)(o + 4) = v1;
                        }
                    } else if (pn < 8) {
                        *(u32x4*)((bf16_t*)(ws + WS_GZ) + (size_t)row * 512 + (pn - 6) * 256 + cc) = w;
                    } else if (pn < 11) {
                        *(u32x4*)((bf16_t*)(ws + WS_SC) + (size_t)row * 768 + (pn - 8) * 256 + cc) = w;
                    } else {
                        const int head = cc >> 6, d = cc & 63;
                        const size_t off = samp ? ((size_t)MP * 256 + ((size_t)(b * 4 + head) * 4 + t) * 64 + d) : (((size_t)(b * 4 + head) * 2048 + t) * 64 + d);
                        bf16_t* dst = (bf16_t*)(ws + ((pn == 11) ? WS_MQ : (pn == 12 ? WS_MK : WS_MV)));
                        *(u32x4*)(dst + off) = w;
                        if (pn >= 12) {
                            const size_t ob = (pn == 12) ? (samp ? O_SK : O_PK) : (samp ? O_SV : O_PV);
                            float* o = out + ob + (samp ? ((size_t)(layer * 128 + b) * 4 + t) * 256 : ((size_t)(layer * 8 + b) * 2048 + t) * 256) + cc;
                            *(f32x4*)o = v0; *(f32x4*)(o + 4) = v1;
                        }
                    }
                }
            }
        }
    }
};
}

constexpr int RTAB_OFF = 131072 + 1024;
template <class Sched> __device__ __forceinline__ void rstd_table(const Sched& S, const float* ssq, LAS unsigned char* lds, const int tid) {
    LAS float* tab = (LAS float*)(lds + RTAB_OFF);
    pg8::Unit u;
    for (int i = 0; i < 6 && S.next(i, u); ++i) if (tid < 256) tab[i * 256 + tid] = pg8::row_rstd(ssq, u.pm * 256 + tid);
    LDS_BARRIER();
}

struct Params { const void* in[25]; float* out; unsigned char* ws; int ph_lo, ph_hi; };

struct Ctx {
    const __attribute__((address_space(4))) Params* P; unsigned char* ws; float* out; int G, wg;
    __device__ __forceinline__ const float* x_prompt() const { return (const float*)(const GAS float*)P->in[0]; }
    __device__ __forceinline__ const float* x_sample() const { return (const float*)(const GAS float*)P->in[1]; }
    __device__ __forceinline__ const float* state_gdn() const { return (const float*)(const GAS float*)P->in[2]; }
    __device__ __forceinline__ const float* state_gdn_conv() const { return (const float*)(const GAS float*)P->in[3]; }
    __device__ __forceinline__ const float* state_sconv() const { return (const float*)(const GAS float*)P->in[4]; }
    __device__ __forceinline__ const float* cache_k() const { return (const float*)(const GAS float*)P->in[5]; }
    __device__ __forceinline__ const float* cache_v() const { return (const float*)(const GAS float*)P->in[6]; }
    __device__ __forceinline__ const int* page_table() const { return (const int*)(const GAS int*)P->in[7]; }
    __device__ __forceinline__ const float* norm_ffn1() const { return (const float*)(const GAS float*)P->in[8]; }
    __device__ __forceinline__ const float* ffn1_w_gate() const { return (const float*)(const GAS float*)P->in[9]; }
    __device__ __forceinline__ const float* ffn1_w_up() const { return (const float*)(const GAS float*)P->in[10]; }
    __device__ __forceinline__ const float* ffn1_w_down() const { return (const float*)(const GAS float*)P->in[11]; }
    __device__ __forceinline__ const float* norm_mix() const { return (const float*)(const GAS float*)P->in[12]; }
    __device__ __forceinline__ const float* w_in() const { return (const float*)(const GAS float*)P->in[13]; }
    __device__ __forceinline__ const float* gdn_conv_w() const { return (const float*)(const GAS float*)P->in[14]; }
    __device__ __forceinline__ const float* gdn_a_log() const { return (const float*)(const GAS float*)P->in[15]; }
    __device__ __forceinline__ const float* gdn_dt_bias() const { return (const float*)(const GAS float*)P->in[16]; }
    __device__ __forceinline__ const float* gdn_norm_w() const { return (const float*)(const GAS float*)P->in[17]; }
    __device__ __forceinline__ const float* sc_conv_w() const { return (const float*)(const GAS float*)P->in[18]; }
    __device__ __forceinline__ const float* w_out() const { return (const float*)(const GAS float*)P->in[19]; }
    __device__ __forceinline__ const float* norm_ffn2() const { return (const float*)(const GAS float*)P->in[20]; }
    __device__ __forceinline__ const float* ffn2_w_gate() const { return (const float*)(const GAS float*)P->in[21]; }
    __device__ __forceinline__ const float* ffn2_w_up() const { return (const float*)(const GAS float*)P->in[22]; }
    __device__ __forceinline__ const float* ffn2_w_down() const { return (const float*)(const GAS float*)P->in[23]; }
    __device__ __forceinline__ const float* norm_final() const { return (const float*)(const GAS float*)P->in[24]; }
    __device__ __forceinline__ float* wba() const { return (float*)(ws + WS_WBA); }
    __device__ __forceinline__ float* xres() const { return (float*)(ws + WS_XRES); }
    __device__ __forceinline__ float* ssq() const { return (float*)(ws + WS_SSQ); }
    __device__ __forceinline__ float* ba() const { return (float*)(ws + WS_BA); }
    __device__ __forceinline__ float* gu() const { return (float*)(ws + WS_GU); }
    __device__ __forceinline__ float* gbc() const { return (float*)(ws + WS_GBC); }
    __device__ __forceinline__ float* gcd() const { return (float*)(ws + WS_GCD); }
    __device__ __forceinline__ bf16_t* xb() const { return (bf16_t*)(ws + WS_XB); }
    __device__ __forceinline__ bf16_t* hid() const { return (bf16_t*)(ws + WS_HID); }
    __device__ __forceinline__ bf16_t* gqkv() const { return (bf16_t*)(ws + WS_GQKV); }
    __device__ __forceinline__ bf16_t* gz() const { return (bf16_t*)(ws + WS_GZ); }
    __device__ __forceinline__ bf16_t* sc() const { return (bf16_t*)(ws + WS_SC); }
    __device__ __forceinline__ bf16_t* mq() const { return (bf16_t*)(ws + WS_MQ); }
    __device__ __forceinline__ bf16_t* mk() const { return (bf16_t*)(ws + WS_MK); }
    __device__ __forceinline__ bf16_t* mv() const { return (bf16_t*)(ws + WS_MV); }
    __device__ __forceinline__ bf16_t* mix() const { return (bf16_t*)(ws + WS_MIX); }
    __device__ __forceinline__ bf16_t* km() const { return (bf16_t*)(ws + WS_KM); }
    __device__ __forceinline__ bf16_t* gw() const { return (bf16_t*)(ws + WS_GW); }
    __device__ __forceinline__ bf16_t* gatt() const { return (bf16_t*)(ws + WS_GATT); }
    __device__ __forceinline__ bf16_t* gqd() const { return (bf16_t*)(ws + WS_GQD); }
    __device__ __forceinline__ bf16_t* gap() const { return (bf16_t*)(ws + WS_GAP); }
    __device__ __forceinline__ bf16_t* gst() const { return (bf16_t*)(ws + WS_GST); }
};

__device__ __forceinline__ bf16x8 tr_frag(const LAS unsigned char* img, int stride_bytes, int row0, int row1, int col0, int lane) {
    const int q = (lane & 15) >> 2, p = lane & 3;
    const s16x4 lo = __builtin_amdgcn_ds_read_tr16_b64_v4i16((LAS s16x4*)(img + (row0 + q) * stride_bytes + (col0 + 4 * p) * 2));
    const s16x4 hi = __builtin_amdgcn_ds_read_tr16_b64_v4i16((LAS s16x4*)(img + (row1 + q) * stride_bytes + (col0 + 4 * p) * 2));
    bf16x8 r; r[0] = lo[0]; r[1] = lo[1]; r[2] = lo[2]; r[3] = lo[3]; r[4] = hi[0]; r[5] = hi[1]; r[6] = hi[2]; r[7] = hi[3];
    return r;
}
#define MFMA16(a, b, c) __builtin_amdgcn_mfma_f32_16x16x32_bf16((a), (b), (c), 0, 0, 0)

#ifndef SG_DEPTH
#define SG_DEPTH 6
#endif
template <int K>
__device__ __forceinline__ void sample_gemm_res(const Ctx& C, const int tid0, const bf16_t* A, const bf16_t* Bt, const float scale, LAS unsigned char* lds) {
    const int tid = tid0, lane = tid & 63, w = tid >> 6, g4 = lane >> 4, l15 = lane & 15;
    LAS f32x4* part = (LAS f32x4*)lds;
    LAS float* ssp = (LAS float*)(lds + 65536);
    constexpr int KW = K / 8, NKS = KW / 32, D = NKS < SG_DEPTH ? NKS : SG_DEPTH;
    for (int pr = C.wg; pr < 256; pr += C.G) {
        const int rt2 = pr >> 4, cg = pr & 15;
        const bf16_t* ap = A + (size_t)(32 * rt2 + l15) * K + w * KW + 8 * g4;
        const bf16_t* bp = Bt + (size_t)(64 * cg + l15) * K + w * KW + 8 * g4;
        f32x4 acc[2][4];
#pragma unroll
        for (int i = 0; i < 2; ++i)
#pragma unroll
            for (int t = 0; t < 4; ++t) acc[i][t] = (f32x4){0.f, 0.f, 0.f, 0.f};
        bf16x8 a[D][2], bb[D][4];
#define SG_LOAD(sl_, ks_) do { _Pragma("unroll") for (int i = 0; i < 2; ++i) a[sl_][i] = *(const bf16x8*)(ap + (size_t)(16 * i) * K + 32 * (ks_)); \
                               _Pragma("unroll") for (int t = 0; t < 4; ++t) bb[sl_][t] = *(const bf16x8*)(bp + (size_t)(16 * t) * K + 32 * (ks_)); } while (0)
#pragma unroll
        for (int s_ = 0; s_ < D; ++s_) SG_LOAD(s_, s_);
#pragma unroll
        for (int ks = 0; ks < NKS; ++ks) {
            const int sl = ks % D;
#pragma unroll
            for (int i = 0; i < 2; ++i)
#pragma unroll
                for (int t = 0; t < 4; ++t) acc[i][t] = MFMA16(a[sl][i], bb[sl][t], acc[i][t]);
            if (ks + D < NKS) SG_LOAD(sl, ks + D);
        }
#undef SG_LOAD
#pragma unroll
        for (int i = 0; i < 2; ++i)
#pragma unroll
            for (int t = 0; t < 4; ++t) part[((w * 8) + i * 4 + t) * 64 + lane] = acc[i][t];
        LDS_BARRIER();
        f32x4 s = part[(0 * 8 + w) * 64 + lane];
#pragma unroll
        for (int q = 1; q < 8; ++q) s = s + part[(q * 8 + w) * 64 + lane];
        const int rti = w >> 2, ct = w & 3, col = 64 * cg + 16 * ct + l15;
#pragma unroll
        for (int r = 0; r < 4; ++r) {
            const size_t row = (size_t)MP + 32 * rt2 + 16 * rti + 4 * g4 + r;
            const float x = bf2f(C.xb()[row * DM + col]) + scale * s[r];
            C.xb()[row * DM + col] = (bf16_t)f2bf(x);
            float ss = x * x;
            ss += __shfl_xor(ss, 1); ss += __shfl_xor(ss, 2); ss += __shfl_xor(ss, 4); ss += __shfl_xor(ss, 8);
            if (l15 == 0) ssp[w * 16 + 4 * g4 + r] = ss;
        }
        LDS_BARRIER();
        if (ct == 0 && lane < 16)
            C.ssq()[((size_t)MP + 32 * rt2 + 16 * rti + lane) * 16 + cg] = (ssp[(rti * 4 + 0) * 16 + lane] + ssp[(rti * 4 + 1) * 16 + lane]) + (ssp[(rti * 4 + 2) * 16 + lane] + ssp[(rti * 4 + 3) * 16 + lane]);
        LDS_BARRIER();
    }
}

__device__ __forceinline__ void tr_item(const float* W, int ldw, int c0, const float* gain, bf16_t* WT, int K, int n0, int k0, LAS float* scr, int lane) {
    float v[32];
#pragma unroll
    for (int i = 0; i < 32; ++i) v[i] = W[(size_t)(k0 + 2 * i + (lane >> 5)) * ldw + c0 + (lane & 31)];
#pragma unroll
    for (int i = 0; i < 32; ++i) scr[(2 * i + (lane >> 5)) * 33 + (lane & 31)] = v[i];
    asm volatile("s_waitcnt lgkmcnt(0)" ::: "memory");
    const int c = lane & 7;
    f32x4 g0 = {1.f, 1.f, 1.f, 1.f}, g1 = {1.f, 1.f, 1.f, 1.f};
    if (gain) { g0 = *(const f32x4*)(gain + k0 + 8 * c); g1 = *(const f32x4*)(gain + k0 + 8 * c + 4); }
#pragma unroll
    for (int j = 0; j < 4; ++j) { const int n = (lane >> 3) + 8 * j; const LAS float* s = scr + (8 * c) * 33 + n;
        u32x4 o; o.x = pk2(s[0 * 33] * g0[0], s[1 * 33] * g0[1]); o.y = pk2(s[2 * 33] * g0[2], s[3 * 33] * g0[3]); o.z = pk2(s[4 * 33] * g1[0], s[5 * 33] * g1[1]); o.w = pk2(s[6 * 33] * g1[2], s[7 * 33] * g1[3]);
        *(u32x4*)(WT + (size_t)(n0 + n) * K + k0 + 8 * c) = o; }
    asm volatile("s_waitcnt lgkmcnt(0)" ::: "memory");
}

constexpr int I_GU = 16 * 176, I_DN = 44 * 32, I_IN = 16 * 112, I_OUT = 16 * 32, I_LAYER = 2 * I_GU + 2 * I_DN + I_IN + I_OUT;
__device__ __forceinline__ void conv_item(const Ctx& C, const int l, int r, LAS float* scr, const int lane) {
    unsigned char* wl = C.ws + WS_W + (size_t)l * W_LAYER;
    int kind, ff = 0;
    if (r < I_GU) { kind = 0; ff = 0; } else if ((r -= I_GU) < I_DN) { kind = 1; ff = 0; } else if ((r -= I_DN) < I_IN) { kind = 2; } else if ((r -= I_IN) < I_OUT) { kind = 3; }
    else if ((r -= I_OUT) < I_GU) { kind = 0; ff = 1; } else { r -= I_GU; kind = 1; ff = 1; }
    if (kind == 0) {
        const int kb = r / 176, nb = r % 176, n0 = 32 * nb, tile = n0 >> 8, within = n0 & 255;
        const float* src = (within < 128) ? (ff ? C.ffn2_w_gate() : C.ffn1_w_gate()) : (ff ? C.ffn2_w_up() : C.ffn1_w_up());
        tr_item(src + (size_t)l * DM * FF, FF, 128 * tile + (within & 127), (ff ? C.norm_ffn2() : C.norm_ffn1()) + l * DM, (bf16_t*)(wl + (ff ? WO_GU2 : WO_GU1)), DM, n0, 64 * kb, scr, lane);
    } else if (kind == 1) {
        const int kb = r / 32, nb = r % 32;
        tr_item((ff ? C.ffn2_w_down() : C.ffn1_w_down()) + (size_t)l * FF * DM, DM, 32 * nb, nullptr, (bf16_t*)(wl + (ff ? WO_DN2 : WO_DN1)), FF, 32 * nb, 64 * kb, scr, lane);
    } else if (kind == 2) {
        const int kb = r / 112, nb = r % 112, n0 = 32 * nb;
        tr_item(C.w_in() + (size_t)l * DM * PROJ, PROJ, n0 < 2048 ? n0 : n0 + 8, C.norm_mix() + l * DM, (bf16_t*)(wl + WO_IN), DM, n0, 64 * kb, scr, lane);
    } else {
        const int kb = r / 32, nb = r % 32;
        tr_item(C.w_out() + (size_t)l * DM * DM, DM, 32 * nb, nullptr, (bf16_t*)(wl + WO_OUT), DM, 32 * nb, 64 * kb, scr, lane);
    }
}
constexpr int GU_UNITS = (MT / 256) * (NGU / 256), I_PRO = I_GU + I_DN, I_LATE0 = I_LAYER - I_DN;
__device__ __forceinline__ bool conv_deferred(const Ctx& C) { return C.G == 256; }
__device__ __forceinline__ void conv_slot_a(const Ctx& C, const int tid0, LAS unsigned char* lds) {
    const int lane = tid0 & 63, wave = tid0 >> 6;
    const int nfull = GU_UNITS % C.G, nidle = C.G - nfull, vi = C.wg - nfull;
    if (vi < 0) return;
    LAS float* scr = (LAS float*)(lds + wave * 16384);
    for (int it = I_PRO + vi * 8 + wave; it < I_LATE0; it += nidle * 8) conv_item(C, 0, it, scr, lane);
}
__device__ __forceinline__ void conv_slot_b(const Ctx& C, const int tid0, const int vi, const int nidle, LAS unsigned char* lds) {
    const int lane = tid0 & 63, wave = tid0 >> 6;
    LAS float* scr = (LAS float*)(lds + wave * 16384);
    for (int it = I_LATE0 + vi * 8 + wave; it < 2 * I_LAYER; it += nidle * 8) conv_item(C, it / I_LAYER, it % I_LAYER, scr, lane);
}
__device__ __forceinline__ void p0_prologue(const Ctx& C, const int tid0, LAS unsigned char* lds) {
    const int tid = tid0, lane = tid & 63, wave = tid >> 6;
    LAS float* scr = (LAS float*)(lds + wave * 16384);
    const int gw = C.wg * 8 + wave, NGW = C.G * 8;
    const int nconv = conv_deferred(C) ? I_PRO : 2 * I_LAYER;
    for (int it = gw; it < nconv; it += NGW) conv_item(C, it / I_LAYER, it % I_LAYER, scr, lane);
    for (int i = C.wg * 512 + tid; i < 2 * 16 * DM; i += C.G * 512) {
        const int l = i >> 14, j = (i >> 10) & 15, k = i & 1023;
        const float wv = (j < 8) ? C.w_in()[((size_t)l * DM + k) * PROJ + 2048 + j] * C.norm_mix()[l * DM + k] : 0.f;
        const unsigned hi = f2bf(wv), lo = f2bf(wv - bf2f(hi));
        bf16_t* t = (bf16_t*)C.wba() + (size_t)l * 2 * 16 * DM;
        t[j * DM + k] = (bf16_t)hi; t[16 * DM + j * DM + k] = (bf16_t)lo;
    }
    for (int i = C.wg * 512 + tid; i < 32 * 16 * 64; i += C.G * 512) if (((i >> 6) & 15) >= 8) C.km()[i] = 0;
    constexpr int U = 3;
    for (int m0 = gw; m0 < MT; m0 += U * NGW) {
        f32x4 v[U][4];
#pragma unroll
        for (int k = 0; k < U; ++k) { const int m = m0 + k * NGW;
            const float* src = (m < MP) ? C.x_prompt() + (size_t)m * DM : C.x_sample() + (size_t)(m - MP) * DM;
#pragma unroll
            for (int j = 0; j < 4; ++j) { v[k][j] = (f32x4){0.f, 0.f, 0.f, 0.f}; if (m < MT) v[k][j] = *(const f32x4*)(src + 4 * lane + 256 * j); } }
#pragma unroll
        for (int k = 0; k < U; ++k) { const int m = m0 + k * NGW;
            if (m < MT) {
                float ss = 0.f;
#pragma unroll
                for (int j = 0; j < 4; ++j) {
                    u32x2 w; w.x = pk2(v[k][j][0], v[k][j][1]); w.y = pk2(v[k][j][2], v[k][j][3]);
                    *(u32x2*)(C.xb() + (size_t)m * DM + 4 * lane + 256 * j) = w;
                    ss += (v[k][j][0] * v[k][j][0] + v[k][j][1] * v[k][j][1]) + (v[k][j][2] * v[k][j][2] + v[k][j][3] * v[k][j][3]);
                }
                ss = wave_sum(ss);
                if (lane < 16) C.ssq()[(size_t)m * 16 + lane] = (lane == 0) ? ss : 0.f;
            }
        }
    }
}

__device__ __forceinline__ void ba_rows(const Ctx& C, const int tid0, int l) {
    const int tid = tid0, lane = tid & 63, wave = tid >> 6, g4 = lane >> 4, l15 = lane & 15;
    const bf16_t* wh = (const bf16_t*)C.wba() + (size_t)l * 2 * 16 * DM + (size_t)l15 * DM + 8 * g4;
    const bf16_t* wl = wh + 16 * DM;
    const int nfull = ((MT / 256) * (NIN / 256)) % C.G, nidle = (nfull == 0) ? C.G : C.G - nfull, vi = (nfull == 0) ? C.wg : C.wg - nfull;
    if (vi >= 0) for (int rt = vi * 8 + wave; rt < MT / 16; rt += nidle * 8) {
        const bf16_t* xp = C.xb() + (size_t)(16 * rt + l15) * DM + 8 * g4;
        f32x4 acc = {0.f, 0.f, 0.f, 0.f};
#pragma unroll 8
        for (int ks = 0; ks < 32; ++ks) {
            const bf16x8 ah = *(const bf16x8*)(xp + 32 * ks);
            const bf16x8 bh = *(const bf16x8*)(wh + 32 * ks), bl = *(const bf16x8*)(wl + 32 * ks);
            acc = MFMA16(ah, bh, acc);
            acc = MFMA16(ah, bl, acc);
        }
        if (l15 < 8) {
            const int h = l15 & 3;
            const float bias = C.gdn_dt_bias()[l * 4 + h], ea = __expf(C.gdn_a_log()[l * 4 + h]);
#pragma unroll
            for (int r = 0; r < 4; ++r) {
                const int row = 16 * rt + 4 * g4 + r;
                const float res = acc[r] * pg8::row_rstd(C.ssq(), row);
                float o;
                if (l15 < 4) o = __builtin_amdgcn_rcpf(1.0f + __expf(-res));
                else { const float xx = res + bias, tt = __expf(xx); const float sp = (xx > 20.f) ? xx : ((xx < -4.f) ? tt * (1.0f - 0.5f * tt) : __logf(1.0f + tt)); o = -ea * sp; }
                C.ba()[(size_t)row * 8 + l15] = o;
            }
        }
    }
}

constexpr int G1_KN = 0, G1_QN = 18432, G1_KB = 36864, G1_VB = 55296, G1_KT = 73728, G1_LM = 92160, G1_TM = 109568, G1_LB = 118784, G1_SC = 128000, G1_WU = 0;
constexpr int G1_ST = 288, G1_WUST = 544, G1_TMST = 144;
#ifndef G1REPS
#define G1REPS 1,1,1,1,1
#endif
constexpr int G1R[5] = {G1REPS};

struct G1Regs { unsigned rowq[11], rowk[11], rowv[11]; float bet, gg; };
__device__ __forceinline__ void g1_load(const Ctx& C, const int tid0, int item, G1Regs& R) {
    const int lane = tid0 & 63, w = tid0 >> 6;
    const int b = item >> 7, h = (item >> 5) & 3, c = item & 31;
    const int grow0 = b * SEQ + 64 * c;
    const int dcol = h * 128 + 2 * lane;
#pragma unroll
    for (int j = 0; j < 11; ++j) {
        const int p = 8 * w - 3 + j;
        R.rowq[j] = 0u; R.rowk[j] = 0u; R.rowv[j] = 0u;
        if (c > 0 || p >= 0) { const bf16_t* rp = C.gqkv() + (size_t)(grow0 + p) * 1536 + dcol; R.rowq[j] = *(const unsigned*)rp; R.rowk[j] = *(const unsigned*)(rp + 512); R.rowv[j] = *(const unsigned*)(rp + 1024); }
    }
    const float* ba = C.ba() + (size_t)(grow0 + lane) * 8;
    R.bet = ba[h]; R.gg = ba[4 + h];
}
__device__ __forceinline__ void g1_chunk(const Ctx& C, const int tid0, int l, int item, int next_item, G1Regs& R, LAS unsigned char* lds) {
    const int tid = tid0, lane = tid & 63, w = tid >> 6, g4 = lane >> 4, l15 = lane & 15;
    const int b = item >> 7, h = (item >> 5) & 3, c = item & 31;
    const int grow0 = b * SEQ + 64 * c;
    LAS float* scal = (LAS float*)(lds + G1_SC);
    LAS float* LM = (LAS float*)(lds + G1_LM);
    float a_gc, a_bet, a_eg, a_ek;
    {
        float x = R.gg;
#pragma unroll
        for (int d = 1; d < 64; d <<= 1) { const float t = __shfl_up(x, d); if (lane >= d) x += t; }
        const float gl = __shfl(x, 63);
        a_gc = x; a_bet = R.bet; a_eg = __expf(x); a_ek = __expf(gl - x);
        if (w == 0) { scal[lane] = a_gc; scal[64 + lane] = a_bet; scal[128 + lane] = a_eg; scal[192 + lane] = a_ek; if (lane == 0) C.gcd()[item] = __expf(gl); }
    }
    unsigned rowq[11], rowk[11], rowv[11];
#pragma unroll
    for (int j = 0; j < 11; ++j) { rowq[j] = R.rowq[j]; rowk[j] = R.rowk[j]; rowv[j] = R.rowv[j]; }
    const int dcol = h * 128 + 2 * lane;
    for (int g1r = 0; g1r < G1R[0]; ++g1r) {
        const float* cw = C.gdn_conv_w() + (size_t)l * 4 * 1536;
        float wq[4][2], wk[4][2], wv[4][2];
#pragma unroll
        for (int tp = 0; tp < 4; ++tp) { wq[tp][0] = cw[tp * 1536 + dcol]; wq[tp][1] = cw[tp * 1536 + dcol + 1]; wk[tp][0] = cw[tp * 1536 + 512 + dcol]; wk[tp][1] = cw[tp * 1536 + 512 + dcol + 1];
            wv[tp][0] = cw[tp * 1536 + 1024 + dcol]; wv[tp][1] = cw[tp * 1536 + 1024 + dcol + 1]; }
        float rq[3][2], rk[3][2], rv[3][2];
#pragma unroll
        for (int j = 0; j < 3; ++j) {
            const unsigned uq = rowq[j], uk = rowk[j], uv = rowv[j];
            rq[j][0] = bf2f(uq & 0xffffu); rq[j][1] = bf2f(uq >> 16); rk[j][0] = bf2f(uk & 0xffffu); rk[j][1] = bf2f(uk >> 16); rv[j][0] = bf2f(uv & 0xffffu); rv[j][1] = bf2f(uv >> 16);
        }
#pragma unroll
        for (int i = 0; i < 8; ++i) {
            const int p = 8 * w + i;
            const unsigned uq = rowq[3 + i], uk = rowk[3 + i], uv = rowv[3 + i];
            float cq[2] = {bf2f(uq & 0xffffu), bf2f(uq >> 16)}, ck[2] = {bf2f(uk & 0xffffu), bf2f(uk >> 16)}, cv[2] = {bf2f(uv & 0xffffu), bf2f(uv >> 16)};
            float yq[2], yk[2], yv[2];
#pragma unroll
            for (int e = 0; e < 2; ++e) {
                yq[e] = silu_f(wq[0][e] * rq[0][e] + wq[1][e] * rq[1][e] + wq[2][e] * rq[2][e] + wq[3][e] * cq[e]);
                yk[e] = silu_f(wk[0][e] * rk[0][e] + wk[1][e] * rk[1][e] + wk[2][e] * rk[2][e] + wk[3][e] * ck[e]);
                yv[e] = silu_f(wv[0][e] * rv[0][e] + wv[1][e] * rv[1][e] + wv[2][e] * rv[2][e] + wv[3][e] * cv[e]);
                rq[0][e] = rq[1][e]; rq[1][e] = rq[2][e]; rq[2][e] = cq[e];
                rk[0][e] = rk[1][e]; rk[1][e] = rk[2][e]; rk[2][e] = ck[e];
                rv[0][e] = rv[1][e]; rv[1][e] = rv[2][e]; rv[2][e] = cv[e];
            }
            const float sq = wave_sum(yq[0] * yq[0] + yq[1] * yq[1]), sk = wave_sum(yk[0] * yk[0] + yk[1] * yk[1]);
            const float nq = __builtin_amdgcn_rsqf(sq + EPS) * 0.08838834764831845f, nk = __builtin_amdgcn_rsqf(sk + EPS);
            const float bet = __builtin_bit_cast(float, __builtin_amdgcn_readlane(__builtin_bit_cast(int, a_bet), p)), eg = __builtin_bit_cast(float, __builtin_amdgcn_readlane(__builtin_bit_cast(int, a_eg), p)), ek = __builtin_bit_cast(float, __builtin_amdgcn_readlane(__builtin_bit_cast(int, a_ek), p));
            const float q0 = yq[0] * nq, q1 = yq[1] * nq, k0 = yk[0] * nk, k1 = yk[1] * nk;
            const int o = p * G1_ST + 4 * lane;
            *(LAS unsigned*)(lds + G1_KN + o) = pk2(k0, k1);
            *(LAS unsigned*)(lds + G1_QN + o) = pk2(q0, q1);
            *(LAS unsigned*)(lds + G1_KB + o) = pk2(k0 * (bet * eg), k1 * (bet * eg));
            *(LAS unsigned*)(lds + G1_VB + o) = pk2(yv[0] * bet, yv[1] * bet);
            *(LAS unsigned*)(lds + G1_KT + o) = pk2(k0 * ek, k1 * ek);
            *(unsigned*)(C.gqd() + ((size_t)item * 64 + p) * 128 + 2 * lane) = pk2(q0 * eg, q1 * eg);
        }
    }
    LDS_BARRIER();
    for (int g1r = 0; g1r < G1R[1]; ++g1r) {
    int lane_c = lane; asm volatile("" : "+v"(lane_c));
    if (w < 4) {
        const int lane = lane_c, g4 = lane >> 4, l15 = lane & 15;
        const int it = w;
        bf16x8 af[4];
#pragma unroll
        for (int ks = 0; ks < 4; ++ks) af[ks] = *(const LAS bf16x8*)(lds + G1_KN + (16 * it + l15) * G1_ST + (32 * ks + 8 * g4) * 2);
        for (int jt = 0; jt <= it; ++jt) {
            f32x4 acc = {0.f, 0.f, 0.f, 0.f};
#pragma unroll
            for (int ks = 0; ks < 4; ++ks) { const bf16x8 bfr = *(const LAS bf16x8*)(lds + G1_KN + (16 * jt + l15) * G1_ST + (32 * ks + 8 * g4) * 2); acc = MFMA16(af[ks], bfr, acc); }
            const int j = 16 * jt + l15; const float gj = scal[j];
#pragma unroll
            for (int r = 0; r < 4; ++r) { const int i = 16 * it + 4 * g4 + r; const float lv = (i > j) ? scal[64 + i] * acc[r] * __expf(scal[i] - gj) : 0.f; LM[i * 68 + j] = lv; *(LAS bf16_t*)(lds + G1_LB + i * G1_TMST + j * 2) = (bf16_t)f2bf(lv); }
        }
    } else {
        const int lane = lane_c, g4 = lane >> 4, l15 = lane & 15;
        const int it = w - 4;
        bf16x8 bq[4];
#pragma unroll
        for (int ks = 0; ks < 4; ++ks) bq[ks] = *(const LAS bf16x8*)(lds + G1_QN + (16 * it + l15) * G1_ST + (32 * ks + 8 * g4) * 2);
        const int i = 16 * it + l15; const float gi = scal[i];
#pragma unroll
        for (int jt = 0; jt < 4; ++jt) {
            f32x4 acc = {0.f, 0.f, 0.f, 0.f};
#pragma unroll
            for (int ks = 0; ks < 4; ++ks) { const bf16x8 ak = *(const LAS bf16x8*)(lds + G1_KN + (16 * jt + l15) * G1_ST + (32 * ks + 8 * g4) * 2); acc = MFMA16(ak, bq[ks], acc); }
            float v[4];
#pragma unroll
            for (int r = 0; r < 4; ++r) { const int j = 16 * jt + 4 * g4 + r; v[r] = (i >= j) ? acc[r] * __expf(gi - scal[j]) : 0.f; }
            u32x2 o; o.x = pk2(v[0], v[1]); o.y = pk2(v[2], v[3]);
            *(u32x2*)(C.gatt() + ((size_t)item * 64 + i) * 64 + 16 * jt + 4 * g4) = o;
        }
    }
    }
    LDS_BARRIER();
    if (w == 0) for (int g1r = 0; g1r < G1R[2]; ++g1r) {
        int lane_d = lane; asm volatile("" : "+v"(lane_d));
        const int d = lane_d >> 4, cc = lane_d & 15;
        const LAS float* Ld = LM + (16 * d) * 68 + 16 * d;
        float t[16];
#pragma unroll
        for (int i = 0; i < 16; ++i) {
            float s0 = 0.f, s1 = 0.f;
#pragma unroll
            for (int j4 = 0; j4 < i; j4 += 4) {
                const f32x4 Lv = *(const LAS f32x4*)(Ld + i * 68 + j4);
                if (j4 + 0 < i) s0 += Lv[0] * t[j4 + 0];
                if (j4 + 1 < i) s1 += Lv[1] * t[j4 + 1];
                if (j4 + 2 < i) s0 += Lv[2] * t[j4 + 2];
                if (j4 + 3 < i) s1 += Lv[3] * t[j4 + 3];
            }
            t[i] = ((cc == i) ? 1.f : 0.f) - (s0 + s1);
        }
#pragma unroll
        for (int i = 0; i < 16; ++i) *(LAS bf16_t*)(lds + G1_TM + (16 * d + i) * G1_TMST + (16 * d + cc) * 2) = (bf16_t)f2bf(t[i]);
    }
    LDS_BARRIER();
    for (int g1r = 0; g1r < G1R[3]; ++g1r) {
        int lane_e = lane; asm volatile("" : "+v"(lane_e));
        const int lane = lane_e, g4 = lane >> 4, l15 = lane & 15;
#pragma unroll
        for (int bi = 0; bi < 4; ++bi) {
            u32x2 tdiag = *(const LAS u32x2*)(lds + G1_TM + (16 * bi + l15) * G1_TMST + (16 * bi + 4 * g4) * 2);
            u32x4 ta4; ta4.x = tdiag.x; ta4.y = tdiag.y; ta4.z = 0u; ta4.w = 0u;
            const bf16x8 tA = __builtin_bit_cast(bf16x8, ta4);
#pragma unroll
            for (int cq = 0; cq < 2; ++cq) {
                const int ct = 2 * w + cq, feat = 16 * ct + l15;
                const LAS unsigned char* img = lds + (ct < 8 ? G1_KB : G1_VB);
                const int col = 16 * (ct & 7) + l15;
                f32x4 y;
#pragma unroll
                for (int e = 0; e < 4; ++e) y[e] = bf2f(*(const LAS bf16_t*)(img + (16 * bi + 4 * g4 + e) * G1_ST + col * 2));
                if (bi > 0) {
                    f32x4 pacc = {0.f, 0.f, 0.f, 0.f};
#pragma unroll
                    for (int s2 = 0; s2 < (bi + 1) / 2; ++s2) {
                        const bool valid = (32 * s2 + 8 * g4) < 16 * bi;
                        u32x4 la = *(const LAS u32x4*)(lds + G1_LB + (16 * bi + l15) * G1_TMST + (32 * s2 + 8 * g4) * 2);
                        u32x4 xb = __builtin_bit_cast(u32x4, tr_frag(lds + G1_WU, G1_WUST, 32 * s2 + 8 * g4, 32 * s2 + 8 * g4 + 4, 16 * ct, lane));
                        if (!valid) { la = (u32x4){0u, 0u, 0u, 0u}; xb = (u32x4){0u, 0u, 0u, 0u}; }
                        pacc = MFMA16(__builtin_bit_cast(bf16x8, la), __builtin_bit_cast(bf16x8, xb), pacc);
                    }
                    y = y - pacc;
                }
                u32x4 yb; yb.x = pk2(y[0], y[1]); yb.y = pk2(y[2], y[3]); yb.z = 0u; yb.w = 0u;
                const f32x4 x = MFMA16(tA, __builtin_bit_cast(bf16x8, yb), ((f32x4){0.f, 0.f, 0.f, 0.f}));
#pragma unroll
                for (int e = 0; e < 4; ++e) {
                    const int pos = 16 * bi + 4 * g4 + e; const float v = x[e];
                    *(LAS bf16_t*)(lds + G1_WU + pos * G1_WUST + feat * 2) = (bf16_t)f2bf(v);
                }
            }
            LDS_BARRIER();
        }
    }
    if (next_item >= 0) g1_load(C, tid0, next_item, R);
    {
        int tid_e = tid; asm volatile("" : "+v"(tid_e));
        const int pos = tid_e >> 3, ch = tid_e & 7;
        bf16_t* wrow = C.gw() + ((size_t)item * 64 + pos) * 128 + ch * 8;
        bf16_t* urow = (bf16_t*)C.gu() + ((size_t)item * 64 + pos) * 128 + ch * 8;
        const LAS unsigned char* src = lds + G1_WU + pos * G1_WUST + ch * 16;
        *(u32x4*)wrow = *(const LAS u32x4*)src; *(u32x4*)(wrow + 64) = *(const LAS u32x4*)(src + 128);
        *(u32x4*)urow = *(const LAS u32x4*)(src + 256); *(u32x4*)(urow + 64) = *(const LAS u32x4*)(src + 384);
    }
    for (int g1r = 0; g1r < G1R[4]; ++g1r) {
        int lane_f = lane; asm volatile("" : "+v"(lane_f));
        const int lane = lane_f, g4 = lane >> 4, l15 = lane & 15;
        bf16x8 wa[2], ka[2];
#pragma unroll
        for (int ks = 0; ks < 2; ++ks) { wa[ks] = tr_frag(lds + G1_WU, G1_WUST, 32 * ks + 8 * g4, 32 * ks + 8 * g4 + 4, 16 * w, lane);
                                         ka[ks] = tr_frag(lds + G1_KT, G1_ST, 32 * ks + 8 * g4, 32 * ks + 8 * g4 + 4, 16 * w, lane); }
#pragma unroll
        for (int at = 0; at < 8; ++at) {
            f32x4 acc = {0.f, 0.f, 0.f, 0.f};
#pragma unroll
            for (int ks = 0; ks < 2; ++ks) { const bf16x8 kb = tr_frag(lds + G1_KT, G1_ST, 32 * ks + 8 * g4, 32 * ks + 8 * g4 + 4, 16 * at, lane); acc = MFMA16(wa[ks], kb, acc); }
            u32x2 o; o.x = pk2(-acc[0], -acc[1]); o.y = pk2(-acc[2], -acc[3]);
            *(u32x2*)(C.gap() + ((size_t)item * 128 + 16 * at + l15) * 128 + 32 * (w >> 1) + 8 * g4 + 4 * (w & 1)) = o;
        }
#pragma unroll
        for (int et = 0; et < 8; ++et) {
            f32x4 acc = {0.f, 0.f, 0.f, 0.f};
#pragma unroll
            for (int ks = 0; ks < 2; ++ks) { const bf16x8 ub = tr_frag(lds + G1_WU, G1_WUST, 32 * ks + 8 * g4, 32 * ks + 8 * g4 + 4, 128 + 16 * et, lane); acc = MFMA16(ka[ks], ub, acc); }
            { u32x2 o; o.x = pk2(acc[0], acc[1]); o.y = pk2(acc[2], acc[3]); *(u32x2*)((bf16_t*)C.gbc() + ((((size_t)item * 8 + et) * 8 + w) * 64 + lane) * 4) = o; }
        }
    }
    LDS_BARRIER();
}

__device__ __forceinline__ void g2_scan(const Ctx& C, const int tid0, int l, int unit, LAS unsigned char* lds) {
    const int tid = tid0, lane = tid & 63, w = tid >> 6, g4 = lane >> 4, l15 = lane & 15;
    const int bh = unit >> 2, sl2 = unit & 3, b = bh >> 2, h = bh & 3;
    f32x4 D[2];
    D[0] = (f32x4){0.f, 0.f, 0.f, 0.f}; D[1] = (f32x4){0.f, 0.f, 0.f, 0.f};
    for (int i = tid; i < 2 * 9216 / 4; i += 512) ((LAS unsigned*)lds)[i] = 0u;
    const bf16_t* ap0 = C.gap() + ((size_t)(bh * 32) * 128 + 16 * w + l15) * 128 + 8 * g4;
    const bf16_t* bc0 = (const bf16_t*)C.gbc() + ((((size_t)(bh * 32) * 8 + 2 * sl2) * 8 + w) * 64 + lane) * 4;
    bf16x8 a0[4], a1[4], a2[4], a3[4]; u32x2 c0[2], c1[2], c2[2], c3[2]; float d0, d1, d2, d3;
#define G2_LOAD(AR, CR, DR, CC) do { _Pragma("unroll") for (int s = 0; s < 4; ++s) AR[s] = *(const bf16x8*)(ap0 + (size_t)(CC) * 16384 + 32 * s); \
        CR[0] = *(const u32x2*)(bc0 + (size_t)(CC) * 16384); CR[1] = *(const u32x2*)(bc0 + (size_t)(CC) * 16384 + 2048); DR = C.gcd()[bh * 32 + (CC)]; } while (0)
#define G2_STEP(AR, CR, DR, CC) do { const int c = (CC); const int item = bh * 32 + c; f32x4 bc[2]; \
        _Pragma("unroll") for (int j = 0; j < 2; ++j) bc[j] = (f32x4){bf2f(CR[j].x & 0xffffu), bf2f(CR[j].x >> 16), bf2f(CR[j].y & 0xffffu), bf2f(CR[j].y >> 16)}; \
        const float cd = DR; bf16x8 a[4]; _Pragma("unroll") for (int s = 0; s < 4; ++s) a[s] = AR[s]; \
        if (c + 4 < 32) G2_LOAD(AR, CR, DR, c + 4); \
        u32x4 bfr[2][4];                                        \
        _Pragma("unroll") for (int j = 0; j < 2; ++j) { const LAS unsigned char* rb = lds + (c & 1) * 9216 + (16 * j + l15) * 288; \
            _Pragma("unroll") for (int s = 0; s < 4; ++s) { const u32x2 lo = *(const LAS u32x2*)(rb + (32 * s + 4 * g4) * 2), hi = *(const LAS u32x2*)(rb + (32 * s + 16 + 4 * g4) * 2); \
                bfr[j][s].x = lo.x; bfr[j][s].y = lo.y; bfr[j][s].z = hi.x; bfr[j][s].w = hi.y; } } \
        _Pragma("unroll") for (int j = 0; j < 2; ++j) { \
            { u32x2 o; o.x = pk2(D[j][0], D[j][1]); o.y = pk2(D[j][2], D[j][3]); *(u32x2*)(C.gst() + ((size_t)item * 128 + 32 * sl2 + 16 * j + l15) * 128 + 16 * w + 4 * g4) = o; } \
            D[j] = D[j] * cd + bc[j]; } \
        asm volatile("s_waitcnt lgkmcnt(0)" ::: "memory"); \
        _Pragma("unroll") for (int s = 0; s < 4; ++s) \
            _Pragma("unroll") for (int j = 0; j < 2; ++j) D[j] = MFMA16(a[s], __builtin_bit_cast(bf16x8, bfr[j][s]), D[j]);     \
        _Pragma("unroll") for (int j = 0; j < 2; ++j) \
            { u32x2 o; o.x = pk2(D[j][0], D[j][1]); o.y = pk2(D[j][2], D[j][3]); *(LAS u32x2*)(lds + ((c + 1) & 1) * 9216 + (16 * j + l15) * 288 + (16 * w + 4 * g4) * 2) = o; } \
        LDS_BARRIER(); } while (0)
    G2_LOAD(a0, c0, d0, 0); G2_LOAD(a1, c1, d1, 1); G2_LOAD(a2, c2, d2, 2); G2_LOAD(a3, c3, d3, 3);
    LDS_BARRIER();
    for (int c4 = 0; c4 < 32; c4 += 4) { G2_STEP(a0, c0, d0, c4); G2_STEP(a1, c1, d1, c4 + 1); G2_STEP(a2, c2, d2, c4 + 2); G2_STEP(a3, c3, d3, c4 + 3); }
#undef G2_LOAD
#undef G2_STEP
    float* so = C.out + O_PGDN + ((size_t)(l * 8 + b) * 4 + h) * 16384;
#pragma unroll
    for (int j = 0; j < 2; ++j)
#pragma unroll
        for (int r = 0; r < 4; ++r) so[(16 * w + 4 * g4 + r) * 128 + 32 * sl2 + 16 * j + l15] = D[j][r];
}

__device__ __forceinline__ void g3_pair(const Ctx& C, const int tid0, int l, int pairidx, LAS unsigned char* lds) {
    const int tid = tid0, lane = tid & 63, w = tid >> 6, g4 = lane >> 4, l15 = lane & 15;
    const int half = w >> 2, pt = w & 3, item = 2 * pairidx + half;
    const int b = item >> 7, h = (item >> 5) & 3, c = item & 31;
    LAS unsigned char* ST = lds + half * 53248;
    LAS unsigned char* UT = ST + 34816;
    {
        const int tl = tid & 255;
        const bf16_t* sp = C.gst() + (size_t)item * 16384;
#pragma unroll
        for (int i = 0; i < 8; ++i) { const int q = tl + 256 * i; *(LAS u32x4*)(ST + (q >> 4) * 272 + (q & 15) * 16) = *(const u32x4*)(sp + (q >> 4) * 128 + (q & 15) * 8); }
    }
    const int pos = 16 * pt + l15;
    const size_t row = (size_t)b * SEQ + 64 * c + pos;
    bf16x8 wf[4], qf[4], af[2]; f32x4 u4[8]; u32x2 zz[8];
#pragma unroll
    for (int ks = 0; ks < 4; ++ks) { wf[ks] = *(const bf16x8*)(C.gw() + ((size_t)item * 64 + pos) * 128 + 32 * ks + 8 * g4); qf[ks] = *(const bf16x8*)(C.gqd() + ((size_t)item * 64 + pos) * 128 + 32 * ks + 8 * g4); }
#pragma unroll
    for (int ks = 0; ks < 2; ++ks) af[ks] = *(const bf16x8*)(C.gatt() + ((size_t)item * 64 + pos) * 64 + 32 * ks + 8 * g4);
#pragma unroll
    for (int dt = 0; dt < 8; ++dt) { const u32x2 ub = *(const u32x2*)((const bf16_t*)C.gu() + ((size_t)item * 64 + pos) * 128 + 16 * dt + 4 * g4); u4[dt] = (f32x4){bf2f(ub.x & 0xffffu), bf2f(ub.x >> 16), bf2f(ub.y & 0xffffu), bf2f(ub.y >> 16)}; zz[dt] = *(const u32x2*)(C.gz() + row * 512 + h * 128 + 16 * dt + 4 * g4); }
    f32x4 nwv[8];
#pragma unroll
    for (int dt = 0; dt < 8; ++dt) nwv[dt] = *(const f32x4*)(C.gdn_norm_w() + l * 128 + 16 * dt + 4 * g4);
    LDS_BARRIER();
    f32x4 accW[8], accO[8];
#pragma unroll
    for (int dt = 0; dt < 8; ++dt) { accW[dt] = (f32x4){0.f, 0.f, 0.f, 0.f}; accO[dt] = (f32x4){0.f, 0.f, 0.f, 0.f};
#pragma unroll
        for (int ks = 0; ks < 4; ++ks) { const bf16x8 a = *(const LAS bf16x8*)(ST + (16 * dt + l15) * 272 + (32 * ks + 8 * g4) * 2); accW[dt] = MFMA16(a, wf[ks], accW[dt]); accO[dt] = MFMA16(a, qf[ks], accO[dt]); } }
#pragma unroll
    for (int dt = 0; dt < 8; ++dt) {
#pragma unroll
        for (int r = 0; r < 4; ++r) *(LAS bf16_t*)(UT + (16 * dt + 4 * g4 + r) * 144 + pos * 2) = (bf16_t)f2bf(u4[dt][r] - accW[dt][r]);
    }
    LDS_BARRIER();
#pragma unroll
    for (int dt = 0; dt < 8; ++dt)
#pragma unroll
        for (int ks = 0; ks < 2; ++ks) { const bf16x8 a = *(const LAS bf16x8*)(UT + (16 * dt + l15) * 144 + (32 * ks + 8 * g4) * 2); accO[dt] = MFMA16(a, af[ks], accO[dt]); }
    float ss = 0.f;
#pragma unroll
    for (int dt = 0; dt < 8; ++dt) ss += (accO[dt][0] * accO[dt][0] + accO[dt][1] * accO[dt][1]) + (accO[dt][2] * accO[dt][2] + accO[dt][3] * accO[dt][3]);
    ss += __shfl_xor(ss, 16); ss += __shfl_xor(ss, 32);
    const float rstd = __builtin_amdgcn_rsqf(ss * (1.0f / 128.0f) + EPS);
#pragma unroll
    for (int dt = 0; dt < 8; ++dt) {
        const int dv0 = 16 * dt + 4 * g4;
        const f32x4 nw = nwv[dt];
        const float z0 = bf2f(zz[dt].x & 0xffffu), z1 = bf2f(zz[dt].x >> 16), z2 = bf2f(zz[dt].y & 0xffffu), z3 = bf2f(zz[dt].y >> 16);
        u32x2 o; o.x = pk2(accO[dt][0] * rstd * nw[0] * silu_f(z0), accO[dt][1] * rstd * nw[1] * silu_f(z1)); o.y = pk2(accO[dt][2] * rstd * nw[2] * silu_f(z2), accO[dt][3] * rstd * nw[3] * silu_f(z3));
        *(u32x2*)(C.mix() + row * DM + h * 128 + dv0) = o;
    }
    LDS_BARRIER();
}

__device__ __forceinline__ void km_item(const Ctx& C, const int tid0, int item, LAS unsigned char* lds) {
    const int tid = tid0, d = tid & 63, part = tid >> 6;
    const int bh = item >> 3, j = item & 7;
    const bf16_t* kp = C.mk() + ((size_t)bh * SEQ + 256 * j + 32 * part) * 64 + d;
    float s = 0.f;
#pragma unroll 8
    for (int i = 0; i < 32; ++i) s += bf2f(kp[i * 64]);
    LAS float* red = (LAS float*)lds;
    red[part * 64 + d] = s;
    LDS_BARRIER();
    if (tid < 64) { float t = 0.f;
#pragma unroll
        for (int q = 0; q < 8; ++q) t += red[q * 64 + tid];
        C.km()[((size_t)bh * 16 + j) * 64 + tid] = (bf16_t)f2bf(t * (1.0f / 256.0f)); }
    LDS_BARRIER();
}

constexpr int MO_K = 0, MO_V = 9216, MO_BUF = 18432, MO_ANY = 36864, MO_LIST = 36880, MO_ST = 144;
__device__ __forceinline__ void moba_tile(const LAS unsigned char* kimg, const LAS unsigned char* vimg, const int kt, const bool own, const bool rowsel, const int qg, const bf16x8 (&qf)[2],
                                          float& mrun, float& lrun, f32x4 (&oacc)[4], const int lane, const int g4, const int l15) {
    f32x4 st[4];
#pragma unroll
    for (int s = 0; s < 4; ++s) { st[s] = (f32x4){0.f, 0.f, 0.f, 0.f};
#pragma unroll
        for (int ks = 0; ks < 2; ++ks) { const bf16x8 a = *(const LAS bf16x8*)(kimg + (16 * s + l15) * MO_ST + (32 * ks + 8 * g4) * 2); st[s] = MFMA16(a, qf[ks], st[s]); } }
    const bool diag = own && (64 * kt + 63 > qg - (lane & 15));
    float tmax = -30000.f;
    if (diag) {
#pragma unroll
        for (int s = 0; s < 4; ++s)
#pragma unroll
            for (int r = 0; r < 4; ++r) { const int key = 64 * kt + 16 * s + 4 * g4 + r; st[s][r] = (key <= qg) ? st[s][r] : -30000.f; tmax = fmaxf(tmax, st[s][r]); }
    } else {
#pragma unroll
        for (int s = 0; s < 4; ++s)
#pragma unroll
            for (int r = 0; r < 4; ++r) tmax = fmaxf(tmax, st[s][r]);
    }
    tmax = fmaxf(tmax, __shfl_xor(tmax, 16)); tmax = fmaxf(tmax, __shfl_xor(tmax, 32));
    const float mnew = fmaxf(mrun, tmax);
    const float alpha = __builtin_amdgcn_exp2f((mrun - mnew) * 1.44269504f);
    mrun = mnew;
    const float mneg = (diag || rowsel) ? -mnew * 1.44269504f : -30000.f;
    float psum = 0.f;
#pragma unroll
    for (int s = 0; s < 4; ++s)
#pragma unroll
        for (int r = 0; r < 4; ++r) { const float pv = __builtin_amdgcn_exp2f(fmaf(st[s][r], 1.44269504f, mneg)); st[s][r] = pv; psum += pv; }
    lrun = lrun * alpha + psum;
    bf16x8 pf[2];
#pragma unroll
    for (int ks = 0; ks < 2; ++ks) { u32x4 o; o.x = pk2(st[2 * ks][0], st[2 * ks][1]); o.y = pk2(st[2 * ks][2], st[2 * ks][3]); o.z = pk2(st[2 * ks + 1][0], st[2 * ks + 1][1]); o.w = pk2(st[2 * ks + 1][2], st[2 * ks + 1][3]);
        pf[ks] = __builtin_bit_cast(bf16x8, o); }
    if (__any(alpha != 1.0f)) {
#pragma unroll
        for (int dt = 0; dt < 4; ++dt) oacc[dt] = oacc[dt] * alpha;
    }
#pragma unroll
    for (int dt = 0; dt < 4; ++dt) {
#pragma unroll
        for (int ks = 0; ks < 2; ++ks) { const bf16x8 va = tr_frag(vimg, MO_ST, 32 * ks + 4 * g4, 32 * ks + 16 + 4 * g4, 16 * dt, lane); oacc[dt] = MFMA16(va, pf[ks], oacc[dt]); }
    }
}
__device__ __forceinline__ void moba_prompt_item(const Ctx& C, const int tid0, int bh, int qt, LAS unsigned char* lds) {
    const int tid = tid0, lane = tid & 63, w = tid >> 6, g4 = lane >> 4, l15 = lane & 15;
    const int bt = qt >> 1;
    const int q0 = 128 * qt + 16 * w, qg = q0 + l15;
    const bf16_t* qp = C.mq() + ((size_t)bh * SEQ + qg) * 64;
    bf16x8 qf[2];
#pragma unroll
    for (int ks = 0; ks < 2; ++ks) qf[ks] = *(const bf16x8*)(qp + 32 * ks + 8 * g4);
    LAS unsigned* anyw = (LAS unsigned*)(lds + MO_ANY);
    LAS int* tl = (LAS int*)(lds + MO_LIST);
    if (tid == 0) anyw[0] = 0u;
    unsigned sel = 0u;
    {
        f32x4 gacc = {0.f, 0.f, 0.f, 0.f};
#pragma unroll
        for (int ks = 0; ks < 2; ++ks) { const bf16x8 a = *(const bf16x8*)(C.km() + ((size_t)bh * 16 + l15) * 64 + 32 * ks + 8 * g4); gacc = MFMA16(a, qf[ks], gacc); }
        float gate[8];
#pragma unroll
        for (int r = 0; r < 4; ++r) { gate[r] = __shfl(gacc[r], l15); gate[4 + r] = __shfl(gacc[r], 16 + l15); }
#pragma unroll
        for (int j = 0; j < 8; ++j) {
            int rank = 0;
#pragma unroll
            for (int i = 0; i < 8; ++i) if (i != j) rank += (i < bt && (gate[i] > gate[j] || (gate[i] == gate[j] && i < j))) ? 1 : 0;
            if (j < bt && rank < 3) sel |= (1u << j);
        }
    }
    LDS_BARRIER();
    {
        unsigned m = sel;
#pragma unroll
        for (int o = 1; o < 64; o <<= 1) m |= (unsigned)__shfl_xor((int)m, o);
        if (lane == 0 && m) atomicOr((unsigned*)anyw, m);
    }
    LDS_BARRIER();
    const int last_tile = 2 * qt + 1;
    if (tid == 0) {
        const unsigned anysel = anyw[0]; int n = 0;
        for (int j = 0; j < bt; ++j) if ((anysel >> j) & 1u) for (int t = 0; t < 4; ++t) tl[n++] = 4 * j + t;
        for (int kt = 4 * bt; kt <= last_tile; ++kt) tl[n++] = kt;
        tl[63] = n;
    }
    LDS_BARRIER();
    const int nt = tl[63];
    float mrun = -30000.f, lrun = 0.f;
    f32x4 oacc[4];
#pragma unroll
    for (int dt = 0; dt < 4; ++dt) oacc[dt] = (f32x4){0.f, 0.f, 0.f, 0.f};
    const int ldr = tid >> 3, ldc = tid & 7;
    const bf16_t* kbase = C.mk() + ((size_t)bh * SEQ + ldr) * 64 + ldc * 8;
    const bf16_t* vbase = C.mv() + ((size_t)bh * SEQ + ldr) * 64 + ldc * 8;
    u32x4 k0, v0, k1, v1, k2, v2;
    k0 = *(const u32x4*)(kbase + (size_t)tl[0] * 4096); v0 = *(const u32x4*)(vbase + (size_t)tl[0] * 4096);
    k1 = k0; v1 = v0; k2 = k0; v2 = v0;
    if (1 < nt) { k1 = *(const u32x4*)(kbase + (size_t)tl[1] * 4096); v1 = *(const u32x4*)(vbase + (size_t)tl[1] * 4096); }
    if (2 < nt) { k2 = *(const u32x4*)(kbase + (size_t)tl[2] * 4096); v2 = *(const u32x4*)(vbase + (size_t)tl[2] * 4096); }
#define MO_STEP(n_, KR, VR) do { const int n = (n_); if (n < nt) { const int kt = tl[n]; const int j = kt >> 2; const bool own = (j == bt); \
        LAS unsigned char* kb = lds + (n & 1) * MO_BUF + MO_K; LAS unsigned char* vb = lds + (n & 1) * MO_BUF + MO_V; \
        *(LAS u32x4*)(kb + ldr * MO_ST + ldc * 16) = KR; *(LAS u32x4*)(vb + ldr * MO_ST + ldc * 16) = VR; \
        if (n + 3 < nt) { const int kn = tl[n + 3]; KR = *(const u32x4*)(kbase + (size_t)kn * 4096); VR = *(const u32x4*)(vbase + (size_t)kn * 4096); } \
        LDS_BARRIER(); \
        moba_tile(kb, vb, kt, own, own || ((sel >> j) & 1u), qg, qf, mrun, lrun, oacc, lane, g4, l15); } } while (0)
    for (int n0 = 0; n0 < nt; n0 += 3) { MO_STEP(n0, k0, v0); MO_STEP(n0 + 1, k1, v1); MO_STEP(n0 + 2, k2, v2); }
#undef MO_STEP
    lrun += __shfl_xor(lrun, 16); lrun += __shfl_xor(lrun, 32);
    const float inv = 1.0f / lrun;
    const int b = bh >> 2, h = bh & 3;
    bf16_t* op = C.mix() + ((size_t)b * SEQ + qg) * DM + 768 + h * 64;
#pragma unroll
    for (int dt = 0; dt < 4; ++dt) { u32x2 o; o.x = pk2(oacc[dt][0] * inv, oacc[dt][1] * inv); o.y = pk2(oacc[dt][2] * inv, oacc[dt][3] * inv); *(u32x2*)(op + 16 * dt + 4 * g4) = o; }
    LDS_BARRIER();
}

__device__ __forceinline__ void shortconv_all(const Ctx& C, const int tid0, int l, const int vi, const int nshare) {
    const float* cw = C.sc_conv_w() + (size_t)l * 3 * 256;
    for (int idx = vi * 512 + tid0; idx < MT * 128; idx += nshare * 512) {
        const int row = idx >> 7, c2 = (idx & 127) * 2;
        const bool samp = row >= MP; const int sr = row - MP;
        const int b = samp ? (sr >> 2) : (row >> 11), t = samp ? (sr & 3) : (row & 2047);
        float ch[3][2];
#pragma unroll
        for (int i = 0; i < 3; ++i) {
            const int tt = t - 2 + i;
            if (tt >= 0) { const bf16_t* p = C.sc() + (size_t)(row - 2 + i) * 768 + c2; const unsigned hh = *(const unsigned*)p, cc = *(const unsigned*)(p + 256);
                ch[i][0] = bf2f(hh & 0xffffu) * bf2f(cc & 0xffffu); ch[i][1] = bf2f(hh >> 16) * bf2f(cc >> 16); }
            else if (samp) { const float* hp = C.state_sconv() + ((size_t)(l * 128 + b) * 2 + (tt + 2)) * 256 + c2; ch[i][0] = hp[0]; ch[i][1] = hp[1]; }
            else { ch[i][0] = 0.f; ch[i][1] = 0.f; }
        }
        const unsigned gg = *(const unsigned*)(C.sc() + (size_t)row * 768 + 512 + c2);
        const float y0 = cw[c2] * ch[0][0] + cw[256 + c2] * ch[1][0] + cw[512 + c2] * ch[2][0];
        const float y1 = cw[c2 + 1] * ch[0][1] + cw[256 + c2 + 1] * ch[1][1] + cw[512 + c2 + 1] * ch[2][1];
        *(unsigned*)(C.mix() + (size_t)row * DM + 512 + c2) = pk2(bf2f(gg & 0xffffu) * y0, bf2f(gg >> 16) * y1);
        const int j = samp ? (t - 2) : (t - 2046);
        if (j >= 0) { float* o = C.out + (samp ? (O_SSCONV + ((size_t)(l * 128 + b) * 2 + j) * 256) : (O_PSCONV + ((size_t)(l * 8 + b) * 2 + j) * 256)) + c2; o[0] = ch[2][0]; o[1] = ch[2][1]; }
    }
}

__device__ __forceinline__ void gdn_sample_pair(const Ctx& C, const int tid0, int l, int it, LAS unsigned char* lds) {
    const int tid = tid0, grp = tid >> 8, tl = tid & 255, e = tl & 127, half = tl >> 7, lane = tid & 63, wsub = (tl >> 6) & 1;
    const int item = it * 2 + grp, b = item >> 2, h = item & 3;
    LAS float* ks = (LAS float*)(lds + grp * 16384);
    LAS float* qs = ks + 512;
    LAS float* pd = qs + 512;
    LAS float* po = pd + 256;
    LAS float* red = po + 1024;
    const size_t row0 = (size_t)MP + 4 * b;
    float yq[4], yk[4], yv[4];
    {
        const float* cw = C.gdn_conv_w() + (size_t)l * 4 * 1536;
        const int col = h * 128 + e;
        float xq[7], xk[7], xv[7];
#pragma unroll
        for (int j = 0; j < 3; ++j) { const float* hp = C.state_gdn_conv() + ((size_t)(l * 128 + b) * 3 + j) * 1536 + col; xq[j] = hp[0]; xk[j] = hp[512]; xv[j] = hp[1024]; }
#pragma unroll
        for (int t = 0; t < 4; ++t) { const bf16_t* rp = C.gqkv() + (row0 + t) * 1536 + col; xq[3 + t] = bf2f(rp[0]); xk[3 + t] = bf2f(rp[512]); xv[3 + t] = bf2f(rp[1024]); }
#pragma unroll
        for (int t = 0; t < 4; ++t) {
            float aq = 0.f, ak = 0.f, av = 0.f;
#pragma unroll
            for (int i = 0; i < 4; ++i) { aq += cw[i * 1536 + col] * xq[t + i]; ak += cw[i * 1536 + 512 + col] * xk[t + i]; av += cw[i * 1536 + 1024 + col] * xv[t + i]; }
            yq[t] = silu_f(aq); yk[t] = silu_f(ak); yv[t] = silu_f(av);
        }
    }
#pragma unroll
    for (int t = 0; t < 4; ++t) { const float a = wave_sum(yq[t] * yq[t]), bb = wave_sum(yk[t] * yk[t]); if (lane == 0 && half == 0) { red[wsub * 12 + t] = a; red[wsub * 12 + 4 + t] = bb; } }
    LDS_BARRIER();
    if (half == 0) {
#pragma unroll
        for (int t = 0; t < 4; ++t) {
            const float sq = red[t] + red[12 + t], sk = red[4 + t] + red[16 + t];
            qs[t * 128 + e] = yq[t] * __builtin_amdgcn_rsqf(sq + EPS) * 0.08838834764831845f;
            ks[t * 128 + e] = yk[t] * __builtin_amdgcn_rsqf(sk + EPS);
        }
    }
    LDS_BARRIER();
    float S[64];
    const float* sp = C.state_gdn() + ((size_t)(l * 128 + b) * 4 + h) * 16384 + (size_t)(64 * half) * 128 + e;
#pragma unroll
    for (int d = 0; d < 64; ++d) S[d] = __builtin_nontemporal_load(sp + d * 128);
    float o[4];
#pragma unroll
    for (int t = 0; t < 4; ++t) {
        const float* bap = C.ba() + (row0 + t) * 8;
        const float bet = bap[h], a = __expf(bap[4 + h]);
        float dot = 0.f;
#pragma unroll
        for (int d4 = 0; d4 < 64; d4 += 4) { const f32x4 kv = *(const LAS f32x4*)(ks + t * 128 + 64 * half + d4); dot += (kv[0] * S[d4] + kv[1] * S[d4 + 1]) + (kv[2] * S[d4 + 2] + kv[3] * S[d4 + 3]); }
        pd[half * 128 + e] = dot;
        LDS_BARRIER();
        const float u = bet * (yv[t] - a * (pd[e] + pd[128 + e]));
        float ot = 0.f;
#pragma unroll
        for (int d4 = 0; d4 < 64; d4 += 4) { const f32x4 kv = *(const LAS f32x4*)(ks + t * 128 + 64 * half + d4); const f32x4 qv = *(const LAS f32x4*)(qs + t * 128 + 64 * half + d4);
#pragma unroll
            for (int i = 0; i < 4; ++i) { S[d4 + i] = a * S[d4 + i] + kv[i] * u; ot += qv[i] * S[d4 + i]; } }
        o[t] = ot;
        LDS_BARRIER();
    }
    float* so = C.out + O_SGDN + ((size_t)(l * 128 + b) * 4 + h) * 16384 + (size_t)(64 * half) * 128 + e;
#pragma unroll
    for (int d = 0; d < 64; ++d) __builtin_nontemporal_store(S[d], so + d * 128);
#pragma unroll
    for (int t = 0; t < 4; ++t) po[(half * 4 + t) * 128 + e] = o[t];
    LDS_BARRIER();
#pragma unroll
    for (int t = 0; t < 4; ++t) { o[t] = po[t * 128 + e] + po[(4 + t) * 128 + e]; const float a = wave_sum(o[t] * o[t]); if (lane == 0 && half == 0) red[wsub * 12 + t] = a; }
    LDS_BARRIER();
    if (half == 0) {
        const float nw = C.gdn_norm_w()[l * 128 + e];
#pragma unroll
        for (int t = 0; t < 4; ++t) {
            const float rstd = __builtin_amdgcn_rsqf((red[t] + red[12 + t]) * (1.0f / 128.0f) + EPS);
            const float z = bf2f(C.gz()[(row0 + t) * 512 + h * 128 + e]);
            C.mix()[(row0 + t) * DM + h * 128 + e] = (bf16_t)f2bf(o[t] * rstd * nw * silu_f(z));
        }
    }
    LDS_BARRIER();
}

constexpr int MS_SC = 0  , MS_Q = 32768  , MS_GATE = 33792  , MS_OWN = 33920  , MS_ML = 33984  ,
              MS_RED = 34048  , MS_ORED = 34304  , MS_STG = 42496  ;
__device__ __forceinline__ void moba_sample_item(const Ctx& C, const int tid0, int l, int item, LAS unsigned char* lds) {
    const int tid = tid0, lane = tid & 63, w = tid >> 6, sub = tid & 15, kidx = tid >> 4;
    const int b = item >> 2, h = item & 3;
    LAS float* sc = (LAS float*)(lds + MS_SC);
    LAS float* qv = (LAS float*)(lds + MS_Q);
    LAS float* gate = (LAS float*)(lds + MS_GATE);
    LAS float* own = (LAS float*)(lds + MS_OWN);
    LAS float* ml = (LAS float*)(lds + MS_ML);
    LAS float* red = (LAS float*)(lds + MS_RED);
    LAS float* ored = (LAS float*)(lds + MS_ORED);
    const size_t sbase = (size_t)MP * 256 + (size_t)(b * 4 + h) * 4 * 64;
    if (tid < 256) qv[tid] = bf2f(C.mq()[sbase + tid]);
    LDS_BARRIER();
    const int* ptab = C.page_table() + b * NPAGES;
    const float* kc = C.cache_k() + (size_t)l * NPOOL * 128 * 256;
    {
        const int g4 = lane >> 4, l15 = lane & 15;
        bf16x8 bq[2];
#pragma unroll
        for (int ks = 0; ks < 2; ++ks) {
            u32x4 o = {0u, 0u, 0u, 0u};
            if (l15 < 4) { const f32x4 a0 = *(const LAS f32x4*)(qv + l15 * 64 + 32 * ks + 4 * g4), a1 = *(const LAS f32x4*)(qv + l15 * 64 + 32 * ks + 16 + 4 * g4);
                o.x = pk2(a0[0], a0[1]); o.y = pk2(a0[2], a0[3]); o.z = pk2(a1[0], a1[1]); o.w = pk2(a1[2], a1[3]); }
            bq[ks] = __builtin_bit_cast(bf16x8, o);
        }
        f32x4 kfA[4][4], kfB[4][4];
#define MS_LOAD(KF, T0) do { _Pragma("unroll") for (int u = 0; u < 4; ++u) { const int p = 16 * ((T0) + 8 * u) + l15; const int page = ptab[p >> 7]; \
            const float* kp = kc + (((size_t)page * 128 + (p & 127)) * 4 + h) * 64 + 4 * g4; \
            KF[u][0] = __builtin_nontemporal_load((const f32x4*)kp); KF[u][1] = __builtin_nontemporal_load((const f32x4*)(kp + 16)); \
            KF[u][2] = __builtin_nontemporal_load((const f32x4*)(kp + 32)); KF[u][3] = __builtin_nontemporal_load((const f32x4*)(kp + 48)); } } while (0)
#define MS_COMP(KF, T0) do { _Pragma("unroll") for (int u = 0; u < 4; ++u) { f32x4 acc = {0.f, 0.f, 0.f, 0.f}; \
            _Pragma("unroll") for (int ks = 0; ks < 2; ++ks) { u32x4 o; o.x = pk2(KF[u][2 * ks][0], KF[u][2 * ks][1]); o.y = pk2(KF[u][2 * ks][2], KF[u][2 * ks][3]); o.z = pk2(KF[u][2 * ks + 1][0], KF[u][2 * ks + 1][1]); o.w = pk2(KF[u][2 * ks + 1][2], KF[u][2 * ks + 1][3]); \
                acc = MFMA16(__builtin_bit_cast(bf16x8, o), bq[ks], acc); } \
            if (l15 < 4) { *(LAS f32x4*)(sc + l15 * 2048 + 16 * ((T0) + 8 * u) + 4 * g4) = acc; } } } while (0)
        MS_LOAD(kfA, w); MS_LOAD(kfB, w + 32);
        MS_COMP(kfA, w); MS_LOAD(kfA, w + 64);
        MS_COMP(kfB, w + 32); MS_LOAD(kfB, w + 96);
        MS_COMP(kfA, w + 64); MS_COMP(kfB, w + 96);
#undef MS_LOAD
#undef MS_COMP
    }
    if (tid < 256) { const int pr = tid >> 4, q = pr >> 2, tp = pr & 3; float s = 0.f;
#pragma unroll
        for (int i = 0; i < 4; ++i) s += qv[q * 64 + 4 * sub + i] * bf2f(C.mk()[sbase + tp * 64 + 4 * sub + i]);
        s += __shfl_xor(s, 1); s += __shfl_xor(s, 2); s += __shfl_xor(s, 4); s += __shfl_xor(s, 8);
        if (sub == 0) own[pr] = s; }
    LDS_BARRIER();
#pragma unroll
    for (int pi = 0; pi < 4; ++pi) { const int pr = 4 * w + pi, q = pr >> 3, j = pr & 7; float s = 0.f;
#pragma unroll
        for (int i = 0; i < 4; ++i) s += sc[q * 2048 + 256 * j + lane + 64 * i];
        s = wave_sum(s); if (lane == 0) gate[q * 8 + j] = s * (1.0f / 256.0f); }
    LDS_BARRIER();
    if (tid < 64) { const int q = (tid >> 3) & 3, j = tid & 7; int rank = 0; const float gj = gate[q * 8 + j];
#pragma unroll
        for (int i = 0; i < 8; ++i) { const float gi = gate[q * 8 + i]; rank += (i != j && (gi > gj || (gi == gj && i < j))) ? 1 : 0; }
        const unsigned long long bal = __ballot(rank < 3);
        if (tid < 32 && j == 0) ((LAS unsigned*)ml)[8 + q] = (unsigned)(bal >> (8 * q)) & 0xffu; }
    LDS_BARRIER();
    unsigned selq[4];
#pragma unroll
    for (int q = 0; q < 4; ++q) selq[q] = ((LAS unsigned*)ml)[8 + q];
    unsigned vmask = selq[0] | selq[1] | selq[2] | selq[3];
    const float* vc = C.cache_v() + (size_t)l * NPOOL * 128 * 256;
    f32x4 vA[8], vB[8];
#define MS_LOADV(VV, J) do { _Pragma("unroll") for (int i = 0; i < 8; ++i) { const int p = 256 * (J) + kidx + 32 * i; const int page = ptab[p >> 7]; \
        VV[i] = __builtin_nontemporal_load((const f32x4*)(vc + (((size_t)page * 128 + (p & 127)) * 4 + h) * 64 + 4 * sub)); } } while (0)
    int jA = __builtin_ctz(vmask); vmask &= vmask - 1u; MS_LOADV(vA, jA);
    int jB = __builtin_ctz(vmask); vmask &= vmask - 1u; MS_LOADV(vB, jB);
    {
        const int q = w >> 1, hf = w & 1; const unsigned sel = ((LAS unsigned*)ml)[8 + q];
        int blk[3]; { int n = 0;
#pragma unroll
            for (int j = 0; j < 8; ++j) if ((sel >> j) & 1u) { if (n == 0) blk[0] = j; else if (n == 1) blk[1] = j; else blk[2] = j; ++n; } }
        float vals[6];
        float mx = -1e30f;
#pragma unroll
        for (int i = 0; i < 6; ++i) { const int idx = hf * 384 + lane + 64 * i; const int sl = idx >> 8; const int bj = (sl == 0) ? blk[0] : (sl == 1 ? blk[1] : blk[2]);
            vals[i] = sc[q * 2048 + 256 * bj + (idx & 255)]; mx = fmaxf(mx, vals[i]); }
        float ov = -1e30f;
        if (hf == 0 && lane <= q) { ov = own[q * 4 + lane]; mx = fmaxf(mx, ov); }
        mx = wave_max(mx);
        if (lane == 0) red[w * 2] = mx;
        LDS_BARRIER();
        const float m = fmaxf(red[(w & ~1) * 2], red[(w | 1) * 2]);
        float s = 0.f;
#pragma unroll
        for (int i = 0; i < 6; ++i) s += __expf(vals[i] - m);
        if (hf == 0 && lane <= q) s += __expf(ov - m);
        s = wave_sum(s);
        if (lane == 0) red[w * 2 + 1] = s;
        LDS_BARRIER();
        if (lane == 0 && hf == 0) { ml[q] = m; ml[4 + q] = red[w * 2 + 1] + red[(w + 1) * 2 + 1]; }
    }
    LDS_BARRIER();
    f32x4 acc[4];
#pragma unroll
    for (int q = 0; q < 4; ++q) acc[q] = (f32x4){0.f, 0.f, 0.f, 0.f};
    float mq_[4];
#pragma unroll
    for (int q = 0; q < 4; ++q) mq_[q] = ml[q];
#define MS_COMPV(VV, J) do { _Pragma("unroll") for (int i = 0; i < 8; ++i) { const int p = 256 * (J) + kidx + 32 * i; \
        _Pragma("unroll") for (int q = 0; q < 4; ++q) { const float wgt = ((selq[q] >> (J)) & 1u) ? __expf(sc[q * 2048 + p] - mq_[q]) : 0.f; acc[q] = acc[q] + VV[i] * wgt; } } } while (0)
    for (;;) {
        MS_COMPV(vA, jA);
        if (vmask) { jA = __builtin_ctz(vmask); vmask &= vmask - 1u; MS_LOADV(vA, jA); } else jA = -1;
        if (jB < 0) break;
        MS_COMPV(vB, jB);
        if (vmask) { jB = __builtin_ctz(vmask); vmask &= vmask - 1u; MS_LOADV(vB, jB); } else jB = -1;
        if (jA < 0) break;
    }
#undef MS_LOADV
#undef MS_COMPV
    if (kidx < 4) {
        const bf16_t* vp = C.mv() + sbase + kidx * 64 + 4 * sub;
        const f32x4 vn = {bf2f(vp[0]), bf2f(vp[1]), bf2f(vp[2]), bf2f(vp[3])};
#pragma unroll
        for (int q = 0; q < 4; ++q) { const float wgt = (kidx <= q) ? __expf(own[q * 4 + kidx] - mq_[q]) : 0.f; acc[q] = acc[q] + vn * wgt; }
    }
#pragma unroll
    for (int q = 0; q < 4; ++q)
#pragma unroll
        for (int i = 0; i < 4; ++i) { float v = acc[q][i]; v += __shfl_xor(v, 16); v += __shfl_xor(v, 32); acc[q][i] = v; }
    if (lane < 16) {
#pragma unroll
        for (int q = 0; q < 4; ++q) *(LAS f32x4*)(ored + (w * 4 + q) * 64 + 4 * sub) = acc[q];
    }
    LDS_BARRIER();
    if (tid < 256) { const int q = tid >> 6, d = tid & 63; float s = 0.f;
#pragma unroll
        for (int ww = 0; ww < 8; ++ww) s += ored[(ww * 4 + q) * 64 + d];
        C.mix()[((size_t)MP + 4 * b + q) * DM + 768 + h * 64 + d] = (bf16_t)f2bf(s / ml[4 + q]); }
    LDS_BARRIER();
}

__device__ __forceinline__ void final_norm(const Ctx& C, const int tid0) {
    const int tid = tid0, lane = tid & 63, wave = tid >> 6;
    const int gw = C.wg * 8 + wave, NGW = C.G * 8;
    constexpr int U = 3;
    for (int m0 = gw; m0 < MT; m0 += U * NGW) {
        u32x2 xo[U][4];
#pragma unroll
        for (int k = 0; k < U; ++k) { const int m = m0 + k * NGW;
#pragma unroll
            for (int j = 0; j < 4; ++j) { xo[k][j] = (u32x2){0u, 0u}; if (m < MT) xo[k][j] = *(const u32x2*)(C.xb() + (size_t)m * DM + 4 * lane + 256 * j); } }
#pragma unroll
        for (int k = 0; k < U; ++k) { const int m = m0 + k * NGW;
            if (m < MT) {
                f32x4 v[4]; float ss = 0.f;
#pragma unroll
                for (int j = 0; j < 4; ++j) { v[j] = (f32x4){bf2f(xo[k][j].x & 0xffffu), bf2f(xo[k][j].x >> 16), bf2f(xo[k][j].y & 0xffffu), bf2f(xo[k][j].y >> 16)};
                    ss += (v[j][0] * v[j][0] + v[j][1] * v[j][1]) + (v[j][2] * v[j][2] + v[j][3] * v[j][3]); }
                const float rs = __builtin_amdgcn_rsqf(wave_sum(ss) * (1.0f / 1024.0f) + EPS);
                float* o = C.out + ((m < MP) ? (O_YP + (size_t)m * DM) : (O_YS + (size_t)(m - MP) * DM));
#pragma unroll
                for (int j = 0; j < 4; ++j) { const f32x4 nw = *(const f32x4*)(C.norm_final() + 4 * lane + 256 * j); *(f32x4*)(o + 4 * lane + 256 * j) = v[j] * rs * nw; }
            }
        }
    }
}

struct HalfBar { LAS unsigned* slots; unsigned gen; int w; };
__device__ __forceinline__ void hb_sync(HalfBar& hb, const int lane) {
    (void)lane;
    hb.gen += 1u;
    unsigned t0, t1, t2, t3, ts; unsigned long long sv;
    const unsigned addr = (unsigned)(size_t)hb.slots, own = addr + 4u * (unsigned)hb.w;
    asm volatile("s_waitcnt lgkmcnt(0)\n\t"
                 "s_mov_b64 %[sv], exec\n\t"
                 "s_mov_b64 exec, 1\n\t"
                 "ds_write_b32 %[own], %[gv]\n"
                 "1:\n\t"
                 "ds_read_b32 %[t0], %[ad]\n\t"
                 "ds_read_b32 %[t1], %[ad] offset:4\n\t"
                 "ds_read_b32 %[t2], %[ad] offset:8\n\t"
                 "ds_read_b32 %[t3], %[ad] offset:12\n\t"
                 "s_waitcnt lgkmcnt(0)\n\t"
                 "v_min_u32 %[t0], %[t0], %[t1]\n\t"
                 "v_min_u32 %[t2], %[t2], %[t3]\n\t"
                 "v_min_u32 %[t0], %[t0], %[t2]\n\t"
                 "s_nop 1\n\t"
                 "v_readfirstlane_b32 %[ts], %[t0]\n\t"
                 "s_cmp_ge_u32 %[ts], %[gs]\n\t"
                 "s_cbranch_scc1 2f\n\t"
                 "s_sleep 1\n\t"
                 "s_branch 1b\n"
                 "2:\n\t"
                 "s_mov_b64 exec, %[sv]"
                 : [t0] "=&v"(t0), [t1] "=&v"(t1), [t2] "=&v"(t2), [t3] "=&v"(t3), [ts] "=&s"(ts), [sv] "=&s"(sv)
                 : [ad] "v"(addr), [own] "v"(own), [gv] "v"(hb.gen), [gs] "s"(hb.gen) : "memory", "scc");
}
__device__ __forceinline__ void hb_sync_cpp(HalfBar& hb) {
    __builtin_amdgcn_fence(__ATOMIC_RELEASE, "workgroup");
    hb.gen += 1u;
    volatile LAS unsigned* sl = (volatile LAS unsigned*)hb.slots;
    sl[hb.w] = hb.gen;
    for (;;) { const unsigned a = sl[0], b = sl[1], c = sl[2], d = sl[3]; const unsigned m = min(min(a, b), min(c, d)); if (__builtin_amdgcn_readfirstlane((int)m) >= (int)hb.gen) break; __builtin_amdgcn_s_sleep(1); }
    __builtin_amdgcn_fence(__ATOMIC_ACQUIRE, "workgroup");
}
#ifndef MS_BT
#define MS_BT 2
#endif
#ifndef HB_G1
#define HB_G1 1
#endif
#ifndef HB_KM
#define HB_KM 1
#endif
#ifndef HB_MS
#define HB_MS 1
#endif
#ifndef HB_GS
#define HB_GS 1
#endif
#define HBS_SEL(f) do { if ((f) == 1) hb_sync(hb, lane); else if ((f) == 2) { LDS_BARRIER(); hb_sync(hb, lane); } else if ((f) == 3) hb_sync_cpp(hb); else if ((f) == 4) { hb_sync(hb, lane); hb_sync(hb, lane); } else LDS_BARRIER(); } while (0)

constexpr int H1_KN = 0, H1_VB = 18432, H1_KT = 36864, H1_QN = 55296, H1_LM = 73728, H1_TM = 91136, H1_LB = 100352, H1_SC = 109568, H1_WU2 = 55296  , H_B = 110592;

__device__ __forceinline__ void g1h_chunk(const Ctx& C, const int tl, int l, int item, LAS unsigned char* lds, HalfBar& hb) {
    const int lane = tl & 63, w = tl >> 6, g4 = lane >> 4, l15 = lane & 15;
    const int b = item >> 7, h = (item >> 5) & 3, c = item & 31;
    const int grow0 = b * SEQ + 64 * c;
    LAS float* scal = (LAS float*)(lds + H1_SC);
    LAS float* LM = (LAS float*)(lds + H1_LM);
    const int dcol = h * 128 + 2 * lane;
    unsigned rowq[19], rowk[19], rowv[19];
#pragma unroll
    for (int j = 0; j < 19; ++j) {
        const int p = 16 * w - 3 + j;
        rowq[j] = 0u; rowk[j] = 0u; rowv[j] = 0u;
        if (c > 0 || p >= 0) { const bf16_t* rp = C.gqkv() + (size_t)(grow0 + p) * 1536 + dcol; rowq[j] = *(const unsigned*)rp; rowk[j] = *(const unsigned*)(rp + 512); rowv[j] = *(const unsigned*)(rp + 1024); }
    }
    float a_gc, a_bet, a_eg, a_ek;
    {
        const float* ba = C.ba() + (size_t)(grow0 + lane) * 8;
        a_bet = ba[h];
        float x = ba[4 + h];
#pragma unroll
        for (int d = 1; d < 64; d <<= 1) { const float t = __shfl_up(x, d); if (lane >= d) x += t; }
        const float gl = __builtin_bit_cast(float, __builtin_amdgcn_readlane(__builtin_bit_cast(int, x), 63));
        a_gc = x; a_eg = __expf(x); a_ek = __expf(gl - x);
        if (w == 0) { scal[lane] = a_gc; scal[64 + lane] = a_bet; scal[128 + lane] = a_eg; scal[192 + lane] = a_ek; if (lane == 0) C.gcd()[item] = __expf(gl); }
    }
    {
        const float* cw = C.gdn_conv_w() + (size_t)l * 4 * 1536;
        float wq[4][2], wk[4][2], wv[4][2];
#pragma unroll
        for (int tp = 0; tp < 4; ++tp) { wq[tp][0] = cw[tp * 1536 + dcol]; wq[tp][1] = cw[tp * 1536 + dcol + 1]; wk[tp][0] = cw[tp * 1536 + 512 + dcol]; wk[tp][1] = cw[tp * 1536 + 512 + dcol + 1];
            wv[tp][0] = cw[tp * 1536 + 1024 + dcol]; wv[tp][1] = cw[tp * 1536 + 1024 + dcol + 1]; }
        float rq[3][2], rk[3][2], rv[3][2];
#pragma unroll
        for (int j = 0; j < 3; ++j) {
            const unsigned uq = rowq[j], uk = rowk[j], uv = rowv[j];
            rq[j][0] = bf2f(uq & 0xffffu); rq[j][1] = bf2f(uq >> 16); rk[j][0] = bf2f(uk & 0xffffu); rk[j][1] = bf2f(uk >> 16); rv[j][0] = bf2f(uv & 0xffffu); rv[j][1] = bf2f(uv >> 16);
        }
#pragma unroll
        for (int i = 0; i < 16; ++i) {
            const int p = 16 * w + i;
            const unsigned uq = rowq[3 + i], uk = rowk[3 + i], uv = rowv[3 + i];
            float cq[2] = {bf2f(uq & 0xffffu), bf2f(uq >> 16)}, ck[2] = {bf2f(uk & 0xffffu), bf2f(uk >> 16)}, cv[2] = {bf2f(uv & 0xffffu), bf2f(uv >> 16)};
            float yq[2], yk[2], yv[2];
#pragma unroll
            for (int e = 0; e < 2; ++e) {
                yq[e] = silu_f(wq[0][e] * rq[0][e] + wq[1][e] * rq[1][e] + wq[2][e] * rq[2][e] + wq[3][e] * cq[e]);
                yk[e] = silu_f(wk[0][e] * rk[0][e] + wk[1][e] * rk[1][e] + wk[2][e] * rk[2][e] + wk[3][e] * ck[e]);
                yv[e] = silu_f(wv[0][e] * rv[0][e] + wv[1][e] * rv[1][e] + wv[2][e] * rv[2][e] + wv[3][e] * cv[e]);
                rq[0][e] = rq[1][e]; rq[1][e] = rq[2][e]; rq[2][e] = cq[e];
                rk[0][e] = rk[1][e]; rk[1][e] = rk[2][e]; rk[2][e] = ck[e];
                rv[0][e] = rv[1][e]; rv[1][e] = rv[2][e]; rv[2][e] = cv[e];
            }
            const float sq = wave_sum(yq[0] * yq[0] + yq[1] * yq[1]), sk = wave_sum(yk[0] * yk[0] + yk[1] * yk[1]);
            const float nq = __builtin_amdgcn_rsqf(sq + EPS) * 0.08838834764831845f, nk = __builtin_amdgcn_rsqf(sk + EPS);
            const float bet = __builtin_bit_cast(float, __builtin_amdgcn_readlane(__builtin_bit_cast(int, a_bet), p)), eg = __builtin_bit_cast(float, __builtin_amdgcn_readlane(__builtin_bit_cast(int, a_eg), p)), ek = __builtin_bit_cast(float, __builtin_amdgcn_readlane(__builtin_bit_cast(int, a_ek), p));
            const float q0 = yq[0] * nq, q1 = yq[1] * nq, k0 = yk[0] * nk, k1 = yk[1] * nk;
            const int o = p * G1_ST + 4 * lane;
            *(LAS unsigned*)(lds + H1_KN + o) = pk2(k0, k1);
            *(LAS unsigned*)(lds + H1_QN + o) = pk2(q0, q1);
            *(LAS unsigned*)(lds + H1_VB + o) = pk2(yv[0] * bet, yv[1] * bet);
            *(LAS unsigned*)(lds + H1_KT + o) = pk2(k0 * ek, k1 * ek);
            *(unsigned*)(C.gqd() + ((size_t)item * 64 + p) * 128 + 2 * lane) = pk2(q0 * eg, q1 * eg);
        }
    }
    HBS_SEL(HB_G1);
    {
        int lane_c = lane; asm volatile("" : "+v"(lane_c));
        const int lane = lane_c, g4 = lane >> 4, l15 = lane & 15;
        const int it = w;
        bf16x8 af[4];
#pragma unroll
        for (int ks = 0; ks < 4; ++ks) af[ks] = *(const LAS bf16x8*)(lds + H1_KN + (16 * it + l15) * G1_ST + (32 * ks + 8 * g4) * 2);
        for (int jt = 0; jt <= it; ++jt) {
            f32x4 acc = {0.f, 0.f, 0.f, 0.f};
#pragma unroll
            for (int ks = 0; ks < 4; ++ks) { const bf16x8 bfr = *(const LAS bf16x8*)(lds + H1_KN + (16 * jt + l15) * G1_ST + (32 * ks + 8 * g4) * 2); acc = MFMA16(af[ks], bfr, acc); }
            const int j = 16 * jt + l15; const float gj = scal[j];
#pragma unroll
            for (int r = 0; r < 4; ++r) { const int i = 16 * it + 4 * g4 + r; const float lv = (i > j) ? scal[64 + i] * acc[r] * __expf(scal[i] - gj) : 0.f; LM[i * 68 + j] = lv; *(LAS bf16_t*)(lds + H1_LB + i * G1_TMST + j * 2) = (bf16_t)f2bf(lv); }
        }
        bf16x8 bq[4];
#pragma unroll
        for (int ks = 0; ks < 4; ++ks) bq[ks] = *(const LAS bf16x8*)(lds + H1_QN + (16 * it + l15) * G1_ST + (32 * ks + 8 * g4) * 2);
        const int i = 16 * it + l15; const float gi = scal[i];
#pragma unroll
        for (int jt = 0; jt < 4; ++jt) {
            f32x4 acc = {0.f, 0.f, 0.f, 0.f};
#pragma unroll
            for (int ks = 0; ks < 4; ++ks) { const bf16x8 ak = *(const LAS bf16x8*)(lds + H1_KN + (16 * jt + l15) * G1_ST + (32 * ks + 8 * g4) * 2); acc = MFMA16(ak, bq[ks], acc); }
            float v[4];
#pragma unroll
            for (int r = 0; r < 4; ++r) { const int j = 16 * jt + 4 * g4 + r; v[r] = (i >= j) ? acc[r] * __expf(gi - scal[j]) : 0.f; }
            u32x2 o; o.x = pk2(v[0], v[1]); o.y = pk2(v[2], v[3]);
            *(u32x2*)(C.gatt() + ((size_t)item * 64 + i) * 64 + 16 * jt + 4 * g4) = o;
        }
    }
    if (lane < 16) {
        int lane_d = lane; asm volatile("" : "+v"(lane_d));
        const int d = w, cc = lane_d & 15;
        const LAS float* Ld = LM + (16 * d) * 68 + 16 * d;
        float t[16];
#pragma unroll
        for (int i = 0; i < 16; ++i) {
            float s0 = 0.f, s1 = 0.f;
#pragma unroll
            for (int j4 = 0; j4 < i; j4 += 4) {
                const f32x4 Lv = *(const LAS f32x4*)(Ld + i * 68 + j4);
                if (j4 + 0 < i) s0 += Lv[0] * t[j4 + 0];
                if (j4 + 1 < i) s1 += Lv[1] * t[j4 + 1];
                if (j4 + 2 < i) s0 += Lv[2] * t[j4 + 2];
                if (j4 + 3 < i) s1 += Lv[3] * t[j4 + 3];
            }
            t[i] = ((cc == i) ? 1.f : 0.f) - (s0 + s1);
        }
#pragma unroll
        for (int i = 0; i < 16; ++i) *(LAS bf16_t*)(lds + H1_TM + (16 * d + i) * G1_TMST + (16 * d + cc) * 2) = (bf16_t)f2bf(t[i]);
    }
    HBS_SEL(HB_G1);
    {
        int lane_e = lane; asm volatile("" : "+v"(lane_e));
        const int lane = lane_e, g4 = lane >> 4, l15 = lane & 15;
#pragma unroll
        for (int bi = 0; bi < 4; ++bi) {
            u32x2 tdiag = *(const LAS u32x2*)(lds + H1_TM + (16 * bi + l15) * G1_TMST + (16 * bi + 4 * g4) * 2);
            u32x4 ta4; ta4.x = tdiag.x; ta4.y = tdiag.y; ta4.z = 0u; ta4.w = 0u;
            const bf16x8 tA = __builtin_bit_cast(bf16x8, ta4);
            float rsc[4];
#pragma unroll
            for (int e = 0; e < 4; ++e) { const int pos = 16 * bi + 4 * g4 + e; rsc[e] = (w < 2) ? scal[64 + pos] * scal[128 + pos] : 1.0f; }
#pragma unroll
            for (int cq = 0; cq < 4; ++cq) {
                const int ct = 4 * w + cq, feat = 16 * ct + l15;
                const LAS unsigned char* img = lds + (w < 2 ? H1_KN : H1_VB);
                const int col = 16 * (ct & 7) + l15;
                f32x4 y;
#pragma unroll
                for (int e = 0; e < 4; ++e) y[e] = bf2f(*(const LAS bf16_t*)(img + (16 * bi + 4 * g4 + e) * G1_ST + col * 2)) * rsc[e];
                if (bi > 0) {
                    f32x4 pacc = {0.f, 0.f, 0.f, 0.f};
#pragma unroll
                    for (int s2 = 0; s2 < (bi + 1) / 2; ++s2) {
                        const bool valid = (32 * s2 + 8 * g4) < 16 * bi;
                        u32x4 la = *(const LAS u32x4*)(lds + H1_LB + (16 * bi + l15) * G1_TMST + (32 * s2 + 8 * g4) * 2);
                        u32x4 xb = __builtin_bit_cast(u32x4, tr_frag(lds + H1_WU2, G1_WUST, 32 * s2 + 8 * g4, 32 * s2 + 8 * g4 + 4, 16 * ct, lane));
                        if (!valid) { la = (u32x4){0u, 0u, 0u, 0u}; xb = (u32x4){0u, 0u, 0u, 0u}; }
                        pacc = MFMA16(__builtin_bit_cast(bf16x8, la), __builtin_bit_cast(bf16x8, xb), pacc);
                    }
                    y = y - pacc;
                }
                u32x4 yb; yb.x = pk2(y[0], y[1]); yb.y = pk2(y[2], y[3]); yb.z = 0u; yb.w = 0u;
                const f32x4 x = MFMA16(tA, __builtin_bit_cast(bf16x8, yb), ((f32x4){0.f, 0.f, 0.f, 0.f}));
#pragma unroll
                for (int e = 0; e < 4; ++e) { const int pos = 16 * bi + 4 * g4 + e; *(LAS bf16_t*)(lds + H1_WU2 + pos * G1_WUST + feat * 2) = (bf16_t)f2bf(x[e]); }
            }
        }
    }
    HBS_SEL(HB_G1);
    {
        int tl_e = tl; asm volatile("" : "+v"(tl_e));
        const int pos = tl_e >> 2, ch = tl_e & 3;
        bf16_t* wrow = C.gw() + ((size_t)item * 64 + pos) * 128;
        bf16_t* urow = (bf16_t*)C.gu() + ((size_t)item * 64 + pos) * 128;
        const LAS unsigned char* src = lds + H1_WU2 + pos * G1_WUST;
#pragma unroll
        for (int k = 0; k < 4; ++k) { const int chunk = ch + 4 * k; *(u32x4*)(wrow + chunk * 8) = *(const LAS u32x4*)(src + chunk * 16); *(u32x4*)(urow + chunk * 8) = *(const LAS u32x4*)(src + 256 + chunk * 16); }
    }
    {
        int lane_f = lane; asm volatile("" : "+v"(lane_f));
        const int lane = lane_f, g4 = lane >> 4, l15 = lane & 15;
#pragma unroll
        for (int hh = 0; hh < 2; ++hh) {
            const int tt = 2 * w + hh;
            bf16x8 wa[2], ka[2];
#pragma unroll
            for (int ks = 0; ks < 2; ++ks) { wa[ks] = tr_frag(lds + H1_WU2, G1_WUST, 32 * ks + 8 * g4, 32 * ks + 8 * g4 + 4, 16 * tt, lane);
                                             ka[ks] = tr_frag(lds + H1_KT, G1_ST, 32 * ks + 8 * g4, 32 * ks + 8 * g4 + 4, 16 * tt, lane); }
#pragma unroll
            for (int at = 0; at < 8; ++at) {
                f32x4 acc = {0.f, 0.f, 0.f, 0.f};
#pragma unroll
                for (int ks = 0; ks < 2; ++ks) { const bf16x8 kb = tr_frag(lds + H1_KT, G1_ST, 32 * ks + 8 * g4, 32 * ks + 8 * g4 + 4, 16 * at, lane); acc = MFMA16(wa[ks], kb, acc); }
                u32x2 o; o.x = pk2(-acc[0], -acc[1]); o.y = pk2(-acc[2], -acc[3]);
                *(u32x2*)(C.gap() + ((size_t)item * 128 + 16 * at + l15) * 128 + 32 * (tt >> 1) + 8 * g4 + 4 * (tt & 1)) = o;
            }
#pragma unroll
            for (int et = 0; et < 8; ++et) {
                f32x4 acc = {0.f, 0.f, 0.f, 0.f};
#pragma unroll
                for (int ks = 0; ks < 2; ++ks) { const bf16x8 ub = tr_frag(lds + H1_WU2, G1_WUST, 32 * ks + 8 * g4, 32 * ks + 8 * g4 + 4, 128 + 16 * et, lane); acc = MFMA16(ka[ks], ub, acc); }
                { u32x2 o; o.x = pk2(acc[0], acc[1]); o.y = pk2(acc[2], acc[3]); *(u32x2*)((bf16_t*)C.gbc() + ((((size_t)item * 8 + et) * 8 + tt) * 64 + lane) * 4) = o; }
            }
        }
    }
    HBS_SEL(HB_G1);
}

__device__ __forceinline__ void gs4_item(const Ctx& C, const int tl, int l, int item, LAS unsigned char* lds, HalfBar& hb) {
    const int grp = 0, e = tl & 127, half = tl >> 7, lane = tl & 63, wsub = (tl >> 6) & 1;
    const int b = item >> 2, h = item & 3;
    LAS float* ks = (LAS float*)(lds + grp * 16384);
    LAS float* qs = ks + 512;
    LAS float* pd = qs + 512;
    LAS float* po = pd + 1024;
    LAS float* red = po + 1024;
    const size_t row0 = (size_t)MP + 4 * b;
    float S[64];
    const float* sp = C.state_gdn() + ((size_t)(l * 128 + b) * 4 + h) * 16384 + (size_t)(64 * half) * 128 + e;
#pragma unroll
    for (int d = 0; d < 64; ++d) S[d] = __builtin_nontemporal_load(sp + d * 128);
    float bet_[4], alog_[4], zv_[4];
#pragma unroll
    for (int t = 0; t < 4; ++t) { const float* bap = C.ba() + (row0 + t) * 8; bet_[t] = bap[h]; alog_[t] = bap[4 + h]; zv_[t] = bf2f(C.gz()[(row0 + t) * 512 + h * 128 + e]); }
    const float nw_ = C.gdn_norm_w()[l * 128 + e];
    float yq[4], yk[4], yv[4];
    {
        const float* cw = C.gdn_conv_w() + (size_t)l * 4 * 1536;
        const int col = h * 128 + e;
        float xq[7], xk[7], xv[7];
#pragma unroll
        for (int j = 0; j < 3; ++j) { const float* hp = C.state_gdn_conv() + ((size_t)(l * 128 + b) * 3 + j) * 1536 + col; xq[j] = hp[0]; xk[j] = hp[512]; xv[j] = hp[1024]; }
#pragma unroll
        for (int t = 0; t < 4; ++t) { const bf16_t* rp = C.gqkv() + (row0 + t) * 1536 + col; xq[3 + t] = bf2f(rp[0]); xk[3 + t] = bf2f(rp[512]); xv[3 + t] = bf2f(rp[1024]); }
#pragma unroll
        for (int t = 0; t < 4; ++t) {
            float aq = 0.f, ak = 0.f, av = 0.f;
#pragma unroll
            for (int i = 0; i < 4; ++i) { aq += cw[i * 1536 + col] * xq[t + i]; ak += cw[i * 1536 + 512 + col] * xk[t + i]; av += cw[i * 1536 + 1024 + col] * xv[t + i]; }
            yq[t] = silu_f(aq); yk[t] = silu_f(ak); yv[t] = silu_f(av);
        }
    }
#pragma unroll
    for (int t = 0; t < 4; ++t) { const float a = wave_sum(yq[t] * yq[t]), bb = wave_sum(yk[t] * yk[t]); if (lane == 0 && half == 0) { red[wsub * 12 + t] = a; red[wsub * 12 + 4 + t] = bb; } }
    HBS_SEL(HB_GS);
    if (half == 0) {
#pragma unroll
        for (int t = 0; t < 4; ++t) {
            const float sq = red[t] + red[12 + t], sk = red[4 + t] + red[16 + t];
            qs[t * 128 + e] = yq[t] * __builtin_amdgcn_rsqf(sq + EPS) * 0.08838834764831845f;
            ks[t * 128 + e] = yk[t] * __builtin_amdgcn_rsqf(sk + EPS);
        }
    }
    HBS_SEL(HB_GS);
    float o[4];
#pragma unroll
    for (int t = 0; t < 4; ++t) {
        const float bet = bet_[t], a = __expf(alog_[t]);
        float dot = 0.f;
#pragma unroll
        for (int d4 = 0; d4 < 64; d4 += 4) { const f32x4 kv = *(const LAS f32x4*)(ks + t * 128 + 64 * half + d4); dot += (kv[0] * S[d4] + kv[1] * S[d4 + 1]) + (kv[2] * S[d4 + 2] + kv[3] * S[d4 + 3]); }
        pd[t * 256 + half * 128 + e] = dot;
        HBS_SEL(HB_GS);
        const float u = bet * (yv[t] - a * (pd[t * 256 + e] + pd[t * 256 + 128 + e]));
        float ot = 0.f;
#pragma unroll
        for (int d4 = 0; d4 < 64; d4 += 4) { const f32x4 kv = *(const LAS f32x4*)(ks + t * 128 + 64 * half + d4); const f32x4 qv = *(const LAS f32x4*)(qs + t * 128 + 64 * half + d4);
#pragma unroll
            for (int i = 0; i < 4; ++i) { S[d4 + i] = a * S[d4 + i] + kv[i] * u; ot += qv[i] * S[d4 + i]; } }
        o[t] = ot;
    }
    float* so = C.out + O_SGDN + ((size_t)(l * 128 + b) * 4 + h) * 16384 + (size_t)(64 * half) * 128 + e;
#pragma unroll
    for (int d = 0; d < 64; ++d) __builtin_nontemporal_store(S[d], so + d * 128);
#pragma unroll
    for (int t = 0; t < 4; ++t) po[(half * 4 + t) * 128 + e] = o[t];
    HBS_SEL(HB_GS);
#pragma unroll
    for (int t = 0; t < 4; ++t) { o[t] = po[t * 128 + e] + po[(4 + t) * 128 + e]; const float a = wave_sum(o[t] * o[t]); if (lane == 0 && half == 0) red[wsub * 12 + t] = a; }
    HBS_SEL(HB_GS);
    if (half == 0) {
        const float nw = nw_;
#pragma unroll
        for (int t = 0; t < 4; ++t) {
            const float rstd = __builtin_amdgcn_rsqf((red[t] + red[12 + t]) * (1.0f / 128.0f) + EPS);
            const float z = zv_[t];
            C.mix()[(row0 + t) * DM + h * 128 + e] = (bf16_t)f2bf(o[t] * rstd * nw * silu_f(z));
        }
    }
    HBS_SEL(HB_GS);
}

__device__ __forceinline__ void ms4_item(const Ctx& C, const int tl, int l, int item, LAS unsigned char* lds, HalfBar& hb) {
    const int tid = tl, lane = tid & 63, w = tid >> 6, sub = tid & 15, kidx = tid >> 4;
    const int b = item >> 2, h = item & 3;
    LAS float* sc = (LAS float*)(lds + MS_SC);
    LAS float* qv = (LAS float*)(lds + MS_Q);
    LAS float* gate = (LAS float*)(lds + MS_GATE);
    LAS float* own = (LAS float*)(lds + MS_OWN);
    LAS float* ml = (LAS float*)(lds + MS_ML);
    LAS float* red = (LAS float*)(lds + MS_RED);
    LAS float* ored = (LAS float*)(lds + MS_ORED);
    const size_t sbase = (size_t)MP * 256 + (size_t)(b * 4 + h) * 4 * 64;
    qv[tid] = bf2f(C.mq()[sbase + tid]);
    LAS int* ptl = (LAS int*)(lds + MS_STG + 9216);
    if (tid < NPAGES) ptl[tid] = C.page_table()[b * NPAGES + tid];
    HBS_SEL(HB_MS);
    const LAS int* ptab = ptl;
    const float* kc = C.cache_k() + (size_t)l * NPOOL * 128 * 256;
    {
        const int g4 = lane >> 4, l15 = lane & 15;
        bf16x8 bq[2];
#pragma unroll
        for (int ks = 0; ks < 2; ++ks) {
            u32x4 o = {0u, 0u, 0u, 0u};
            if (l15 < 4) { const f32x4 a0 = *(const LAS f32x4*)(qv + l15 * 64 + 32 * ks + 8 * g4), a1 = *(const LAS f32x4*)(qv + l15 * 64 + 32 * ks + 8 * g4 + 4);
                o.x = pk2(a0[0], a0[1]); o.y = pk2(a0[2], a0[3]); o.z = pk2(a1[0], a1[1]); o.w = pk2(a1[2], a1[3]); }
            bq[ks] = __builtin_bit_cast(bf16x8, o);
        }
        LAS unsigned char* stg = lds + MS_STG + w * 2304;
        f32x4 kfA[MS_BT][4], kfB[MS_BT][4];
#define MS_LOAD(KF, T0) do { _Pragma("unroll") for (int u = 0; u < MS_BT; ++u) { const int t_ = (T0) + 4 * u; const int page = ptab[t_ >> 3]; \
            const float* kp = kc + (((size_t)page * 128 + (16 * (t_ & 7) + g4)) * 4 + h) * 64 + 4 * l15; \
            KF[u][0] = __builtin_nontemporal_load((const f32x4*)kp); KF[u][1] = __builtin_nontemporal_load((const f32x4*)(kp + 4 * 256)); \
            KF[u][2] = __builtin_nontemporal_load((const f32x4*)(kp + 8 * 256)); KF[u][3] = __builtin_nontemporal_load((const f32x4*)(kp + 12 * 256)); } } while (0)
#define MS_COMP(KF, T0) do { _Pragma("unroll") for (int u = 0; u < MS_BT; ++u) { \
            _Pragma("unroll") for (int j = 0; j < 4; ++j) { u32x2 o; o.x = pk2(KF[u][j][0], KF[u][j][1]); o.y = pk2(KF[u][j][2], KF[u][j][3]); *(LAS u32x2*)(stg + (4 * j + g4) * 144 + l15 * 8) = o; } \
            f32x4 acc = {0.f, 0.f, 0.f, 0.f}; \
            _Pragma("unroll") for (int ks = 0; ks < 2; ++ks) { const bf16x8 a = *(const LAS bf16x8*)(stg + l15 * 144 + (32 * ks + 8 * g4) * 2); acc = MFMA16(a, bq[ks], acc); } \
            if (l15 < 4) { *(LAS f32x4*)(sc + l15 * 2048 + 16 * ((T0) + 4 * u) + 4 * g4) = acc; } } } while (0)
        constexpr int BS = 4 * MS_BT, NB2 = 128 / (2 * BS);
        MS_LOAD(kfA, w); MS_LOAD(kfB, w + BS);
        for (int k2 = 0; k2 < NB2 - 1; ++k2) { MS_COMP(kfA, w + 2 * BS * k2); MS_LOAD(kfA, w + 2 * BS * k2 + 2 * BS); MS_COMP(kfB, w + 2 * BS * k2 + BS); MS_LOAD(kfB, w + 2 * BS * k2 + 3 * BS); }
        MS_COMP(kfA, w + 2 * BS * (NB2 - 1)); MS_COMP(kfB, w + 2 * BS * (NB2 - 1) + BS);
#undef MS_LOAD
#undef MS_COMP
    }
    { const int pr = tid >> 4, q = pr >> 2, tp = pr & 3; float s = 0.f;
#pragma unroll
        for (int i = 0; i < 4; ++i) s += qv[q * 64 + 4 * sub + i] * bf2f(C.mk()[sbase + tp * 64 + 4 * sub + i]);
        s += __shfl_xor(s, 1); s += __shfl_xor(s, 2); s += __shfl_xor(s, 4); s += __shfl_xor(s, 8);
        if (sub == 0) own[pr] = s; }
    HBS_SEL(HB_MS);
    {
        float g[8];
#pragma unroll
        for (int j = 0; j < 8; ++j) { float s_ = 0.f;
#pragma unroll
            for (int i = 0; i < 4; ++i) s_ += sc[w * 2048 + 256 * j + lane + 64 * i];
            g[j] = wave_sum(s_) * (1.0f / 256.0f); }
        const int j = lane & 7;
        float gj = g[0];
#pragma unroll
        for (int i = 1; i < 8; ++i) gj = (j == i) ? g[i] : gj;
        int rank = 0;
#pragma unroll
        for (int i = 0; i < 8; ++i) rank += (i != j && (g[i] > gj || (g[i] == gj && i < j))) ? 1 : 0;
        const unsigned long long bal = __ballot(rank < 3);
        if (lane == 0) ((LAS unsigned*)ml)[8 + w] = (unsigned)bal & 0xffu;
    }
    HBS_SEL(HB_MS);
    unsigned selq[4];
#pragma unroll
    for (int q = 0; q < 4; ++q) selq[q] = ((LAS unsigned*)ml)[8 + q];
    unsigned vmask = selq[0] | selq[1] | selq[2] | selq[3];
    const float* vc = C.cache_v() + (size_t)l * NPOOL * 128 * 256;
    f32x4 vA[8], vB[8];
#define MS_LOADV(VV, J, HF) do { _Pragma("unroll") for (int i = 0; i < 8; ++i) { const int p = 256 * (J) + kidx + 16 * (8 * (HF) + i); const int page = ptab[p >> 7]; \
        VV[i] = __builtin_nontemporal_load((const f32x4*)(vc + (((size_t)page * 128 + (p & 127)) * 4 + h) * 64 + 4 * sub)); } } while (0)
    int jcur = __builtin_ctz(vmask); vmask &= vmask - 1u;
    MS_LOADV(vA, jcur, 0); MS_LOADV(vB, jcur, 1);
    u32x2 vown = {0u, 0u};
    if (kidx < 4) vown = *(const u32x2*)(C.mv() + sbase + kidx * 64 + 4 * sub);
    {
        const int q = w; const unsigned sel = ((LAS unsigned*)ml)[8 + q];
        int blk[3]; { int n = 0;
#pragma unroll
            for (int j = 0; j < 8; ++j) if ((sel >> j) & 1u) { if (n == 0) blk[0] = j; else if (n == 1) blk[1] = j; else blk[2] = j; ++n; } }
        float vals[12];
        float mx = -1e30f;
#pragma unroll
        for (int i = 0; i < 12; ++i) { const int idx = lane + 64 * i; const int sl = idx >> 8; const int bj = (sl == 0) ? blk[0] : (sl == 1 ? blk[1] : blk[2]);
            vals[i] = sc[q * 2048 + 256 * bj + (idx & 255)]; mx = fmaxf(mx, vals[i]); }
        float ov = -1e30f;
        if (lane <= q) { ov = own[q * 4 + lane]; mx = fmaxf(mx, ov); }
        const float m = wave_max(mx);
        float s = 0.f;
#pragma unroll
        for (int i = 0; i < 12; ++i) s += __expf(vals[i] - m);
        if (lane <= q) s += __expf(ov - m);
        s = wave_sum(s);
        if (lane == 0) { ml[q] = m; ml[4 + q] = s; }
    }
    HBS_SEL(HB_MS);
    f32x4 acc[4];
#pragma unroll
    for (int q = 0; q < 4; ++q) acc[q] = (f32x4){0.f, 0.f, 0.f, 0.f};
    float mq_[4];
#pragma unroll
    for (int q = 0; q < 4; ++q) mq_[q] = ml[q];
#define MS_COMPV(VV, J, HF) do { float sf_[4]; _Pragma("unroll") for (int q = 0; q < 4; ++q) sf_[q] = (float)((selq[q] >> (J)) & 1u);     \
        _Pragma("unroll") for (int i = 0; i < 8; ++i) { const int p = 256 * (J) + kidx + 16 * (8 * (HF) + i); \
        _Pragma("unroll") for (int q = 0; q < 4; ++q) { const float wgt = __expf(fminf(sc[q * 2048 + p] - mq_[q], 0.f)) * sf_[q]; acc[q] = acc[q] + VV[i] * wgt; } } } while (0)
    for (;;) {
        MS_COMPV(vA, jcur, 0);
        int jn = -1;
        if (vmask) { jn = __builtin_ctz(vmask); vmask &= vmask - 1u; MS_LOADV(vA, jn, 0); }
        MS_COMPV(vB, jcur, 1);
        if (jn < 0) break;
        MS_LOADV(vB, jn, 1);
        jcur = jn;
    }
#undef MS_LOADV
#undef MS_COMPV
    if (kidx < 4) {
        const f32x4 vn = {bf2f(vown.x & 0xffffu), bf2f(vown.x >> 16), bf2f(vown.y & 0xffffu), bf2f(vown.y >> 16)};
#pragma unroll
        for (int q = 0; q < 4; ++q) { const float wgt = (kidx <= q) ? __expf(own[q * 4 + kidx] - mq_[q]) : 0.f; acc[q] = acc[q] + vn * wgt; }
    }
#pragma unroll
    for (int q = 0; q < 4; ++q)
#pragma unroll
        for (int i = 0; i < 4; ++i) { float v = acc[q][i]; v += __shfl_xor(v, 16); v += __shfl_xor(v, 32); acc[q][i] = v; }
    if (lane < 16) {
#pragma unroll
        for (int q = 0; q < 4; ++q) *(LAS f32x4*)(ored + (w * 4 + q) * 64 + 4 * sub) = acc[q];
    }
    HBS_SEL(HB_MS);
    { const int q = tid >> 6, d = tid & 63; float s = 0.f;
#pragma unroll
        for (int ww = 0; ww < 4; ++ww) s += ored[(ww * 4 + q) * 64 + d];
        C.mix()[((size_t)MP + 4 * b + q) * DM + 768 + h * 64 + d] = (bf16_t)f2bf(s / ml[4 + q]); }
    HBS_SEL(HB_MS);
}


__device__ __forceinline__ void km4_item(const Ctx& C, const int tl, int item, LAS unsigned char* lds, HalfBar& hb) {
    const int lane = tl & 63, w = tl >> 6, cg = tl & 7, r0 = tl >> 3;
    const int bh = item >> 3, j = item & 7;
    const bf16_t* kp = C.mk() + ((size_t)bh * SEQ + 256 * j + r0) * 64 + 8 * cg;
    u32x4 v[8];
#pragma unroll
    for (int i = 0; i < 8; ++i) v[i] = *(const u32x4*)(kp + (size_t)i * 32 * 64);
    float s[8];
#pragma unroll
    for (int e = 0; e < 8; ++e) s[e] = 0.f;
#pragma unroll
    for (int i = 0; i < 8; ++i) { s[0] += bf2f(v[i].x & 0xffffu); s[1] += bf2f(v[i].x >> 16); s[2] += bf2f(v[i].y & 0xffffu); s[3] += bf2f(v[i].y >> 16);
                                  s[4] += bf2f(v[i].z & 0xffffu); s[5] += bf2f(v[i].z >> 16); s[6] += bf2f(v[i].w & 0xffffu); s[7] += bf2f(v[i].w >> 16); }
#pragma unroll
    for (int e = 0; e < 8; ++e) { s[e] += __shfl_xor(s[e], 8); s[e] += __shfl_xor(s[e], 16); s[e] += __shfl_xor(s[e], 32); }
    LAS float* red = (LAS float*)lds;
    if (lane < 8) {
#pragma unroll
        for (int e = 0; e < 8; ++e) red[w * 64 + 8 * lane + e] = s[e];
    }
    HBS_SEL(HB_KM);
    if (tl < 64) C.km()[((size_t)bh * 16 + j) * 64 + tl] = (bf16_t)f2bf(((red[tl] + red[64 + tl]) + (red[128 + tl] + red[192 + tl])) * (1.0f / 256.0f));
    HBS_SEL(HB_KM);
}

__device__ __forceinline__ void scv4_all(const Ctx& C, const int tl, int l, const int lo = 0, const int hi = MT * 128) {
    const float* cw = C.sc_conv_w() + (size_t)l * 3 * 256;
    constexpr int U = 4;
    const int stride = C.G * 256;
    for (int idx0 = lo + C.wg * 256 + tl; idx0 < hi; idx0 += U * stride) {
        unsigned A[U][3], B[U][3], gg[U];
#pragma unroll
        for (int k = 0; k < U; ++k) {
            const int idx = idx0 + k * stride; const bool valid = idx < hi;
            const int row = idx >> 7, c2 = (idx & 127) * 2;
            const bool samp = row >= MP; const int sr = row - MP;
            const int b = samp ? (sr >> 2) : (row >> 11), t = samp ? (sr & 3) : (row & 2047);
#pragma unroll
            for (int i = 0; i < 3; ++i) {
                const int tt = t - 2 + i;
                A[k][i] = 0u; B[k][i] = 0u;
                if (valid && tt >= 0) { const bf16_t* p = C.sc() + (size_t)(row - 2 + i) * 768 + c2; A[k][i] = *(const unsigned*)p; B[k][i] = *(const unsigned*)(p + 256); }
                else if (valid && samp) { const float* hp = C.state_sconv() + ((size_t)(l * 128 + b) * 2 + (tt + 2)) * 256 + c2; A[k][i] = __float_as_uint(hp[0]); B[k][i] = __float_as_uint(hp[1]); }
            }
            gg[k] = valid ? *(const unsigned*)(C.sc() + (size_t)row * 768 + 512 + c2) : 0u;
        }
#pragma unroll
        for (int k = 0; k < U; ++k) {
            const int idx = idx0 + k * stride;
            if (idx < hi) {
                const int row = idx >> 7, c2 = (idx & 127) * 2;
                const bool samp = row >= MP; const int sr = row - MP;
                const int b = samp ? (sr >> 2) : (row >> 11), t = samp ? (sr & 3) : (row & 2047);
                float ch[3][2];
#pragma unroll
                for (int i = 0; i < 3; ++i) {
                    const int tt = t - 2 + i;
                    if (tt >= 0) { ch[i][0] = bf2f(A[k][i] & 0xffffu) * bf2f(B[k][i] & 0xffffu); ch[i][1] = bf2f(A[k][i] >> 16) * bf2f(B[k][i] >> 16); }
                    else { ch[i][0] = __uint_as_float(A[k][i]); ch[i][1] = __uint_as_float(B[k][i]); }
                }
                const float y0 = cw[c2] * ch[0][0] + cw[256 + c2] * ch[1][0] + cw[512 + c2] * ch[2][0];
                const float y1 = cw[c2 + 1] * ch[0][1] + cw[256 + c2 + 1] * ch[1][1] + cw[512 + c2 + 1] * ch[2][1];
                *(unsigned*)(C.mix() + (size_t)row * DM + 512 + c2) = pk2(bf2f(gg[k] & 0xffffu) * y0, bf2f(gg[k] >> 16) * y1);
                const int j = samp ? (t - 2) : (t - 2046);
                if (j >= 0) { float* o = C.out + (samp ? (O_SSCONV + ((size_t)(l * 128 + b) * 2 + j) * 256) : (O_PSCONV + ((size_t)(l * 8 + b) * 2 + j) * 256)) + c2; o[0] = ch[2][0]; o[1] = ch[2][1]; }
            }
        }
    }
}


#ifndef ONLY
#define ONLY -1
#endif
#ifndef SUB
#define SUB -1
#endif
#define PHEN(k) (ONLY < 0 || ONLY == (k))
#define G3_PAIR(it) ((C.G == 256) ? (64 * ((it) & 7) + 32 * ((it) >> 8) + (((it) & 255) >> 3)) : (it))
#define G1_ITEM(it) ((C.G == 256) ? (2 * G3_PAIR(((it) & 255) + 256 * ((it) >> 9)) + (((it) >> 8) & 1)) : (it))
#ifndef HALF_A_PRIO
#define HALF_A_PRIO 3
#endif
#ifndef SCV_SPLIT
#define SCV_SPLIT (MT * 128)
#endif
#ifndef GS_SPLIT
#define GS_SPLIT 512
#endif
#ifndef HREPS
#define HREPS 1,1,1,1,1
#endif
constexpr int HREP_[5] = {HREPS};
#define HREP_G1 HREP_[0]
#define HREP_KM HREP_[1]
#define HREP_SCV HREP_[2]
#define HREP_MS HREP_[3]
#define HREP_GS HREP_[4]
#ifndef REPS
#define REPS 1,1,1,1,1,1,1,1,1,1,1,1,1,1
#endif
constexpr int REP[14] = {REPS};
#define SUBEN(k) (SUB < 0 || SUB == (k))
constexpr int N_PHASES = 20;

__global__ void __launch_bounds__(512, 2) mk_fwd(Params p) {
    extern __shared__ __attribute__((aligned(16))) unsigned char lds_raw[];
    LAS unsigned char* lds = (LAS unsigned char*)lds_raw;
    volatile LAS unsigned* MISC = (volatile LAS unsigned*)(lds + MISC_OFF);
    const int tid = threadIdx.x;
#define PH_BEGIN() int tidp = threadIdx.x; asm volatile("" : "+v"(tidp)); Ctx Cp = C; { size_t zoff_ = 0; asm volatile("" : "+s"(zoff_), "+s"(Cp.wg), "+s"(Cp.G)); Cp.ws = C.ws + zoff_; Cp.P = (const __attribute__((address_space(4))) Params*)((const __attribute__((address_space(4))) char*)C.P + zoff_); }
    Ctx C;
    C.P = (const __attribute__((address_space(4))) Params*)__builtin_amdgcn_kernarg_segment_ptr(); C.ws = p.ws; C.out = p.out;
    unsigned char* ws = p.ws;
    C.G = gridDim.x; C.wg = blockIdx.x;

    for (int u = tid; u < (LDS_BYTES - 131072) / 4; u += 512) ((LAS unsigned*)(lds + 131072))[u] = 0u;
    __syncthreads();
    int lo = p.ph_lo, hi = p.ph_hi;
    const bool one = (hi - lo) > 1;
    XcdBarrier bar; bar.bar = (unsigned*)(ws + WS_CTL) + CW_BAR; bar.x = 0; bar.st = nullptr;
    if (one) bar = xcd_barrier_post((unsigned*)(ws + WS_CTL) + CW_BAR, MISC + 8);
#define IN(k) (lo <= (k) && (k) < hi)
#define SEAM(k) do { if (IN(k) && IN((k) + 1)) { XcdBarrier b2_ = bar; size_t zb_ = 0; asm volatile("" : "+s"(zb_), "+s"(b2_.x)); b2_.bar = bar.bar + zb_; xcd_barrier(b2_); } } while (0)

    if (PHEN(100) && IN(0)) { for (int rep = 0; rep < REP[0]; ++rep) { PH_BEGIN(); p0_prologue(Cp, tidp, lds); } }
    SEAM(0);
    for (int l = 0; l < 2; ++l) {
        const int base = 1 + 9 * l;
        asm volatile("" : "+s"(lo), "+s"(hi));

        if (PHEN(0) && IN(base + 0)) for (int rep = 0; rep < REP[1]; ++rep) {
            PH_BEGIN();
            pg8::Gemm g{Cp.xb(), (const bf16_t*)(Cp.ws + WS_W + (size_t)l * W_LAYER + WO_GU1), MT, NGU, DM}; pg8::StaticOrder S; S.init(MT, NGU, Cp.G, Cp.wg);
            rstd_table(S, Cp.ssq(), lds, tidp); pg8::EpiGU E{(const LAS float*)(lds + RTAB_OFF), Cp.hid()};
            pg8::gemm_phase<pg8::EpiGU, pg8::StaticOrder, true, true>(lds, g, S, E, tidp);
            if (l == 0 && conv_deferred(Cp)) { PH_BEGIN(); conv_slot_a(Cp, tidp, lds); }
        }
        SEAM(base + 0);
        if (PHEN(1) && IN(base + 1)) {
            PH_BEGIN();
            pg8::Gemm g{Cp.hid(), (const bf16_t*)(Cp.ws + WS_W + (size_t)l * W_LAYER + WO_DN1), MP, DM, FF}; pg8::StaticOrder S; S.init(MP, DM, Cp.G, Cp.wg);
            for (int rep = 1; rep < REP[12]; ++rep) { pg8::EpiNull EN{Cp.ssq()}; pg8::gemm_phase<pg8::EpiNull, pg8::StaticOrder, true, true>(lds, g, S, EN, tidp); }
            pg8::EpiRES E{Cp.xres(), Cp.xb(), Cp.ssq(), 0.5f};
            pg8::gemm_phase<pg8::EpiRES, pg8::StaticOrder, true, true>(lds, g, S, E, tidp);
            { PH_BEGIN(); sample_gemm_res<FF>(Cp, tidp, Cp.hid() + (size_t)MP * FF, (const bf16_t*)(Cp.ws + WS_W + (size_t)l * W_LAYER + WO_DN1), 0.5f, lds); }
        }
        SEAM(base + 1);
        if (PHEN(2) && IN(base + 2)) for (int rep = 0; rep < REP[2]; ++rep) {
            PH_BEGIN();
            pg8::Gemm g{Cp.xb(), (const bf16_t*)(Cp.ws + WS_W + (size_t)l * W_LAYER + WO_IN), MT, NIN, DM}; pg8::StaticOrder S; S.init(MT, NIN, Cp.G, Cp.wg);
            rstd_table(S, Cp.ssq(), lds, tidp); pg8::EpiIN E{Cp.ws, Cp.out, l, (const LAS float*)(lds + RTAB_OFF)};
            pg8::gemm_phase<pg8::EpiIN, pg8::StaticOrder, true, true>(lds, g, S, E, tidp);
            { PH_BEGIN(); ba_rows(Cp, tidp, l); }
        }
        SEAM(base + 2);
        if (PHEN(3) && IN(base + 3)) {
            int tid3 = threadIdx.x; asm volatile("" : "+v"(tid3));
            const int w8 = __builtin_amdgcn_readfirstlane(tid3 >> 6);
            LAS unsigned* hslots = (LAS unsigned*)(lds + MISC_OFF + 128) + (w8 >> 2) * 16;
            LDS_BARRIER();
            HalfBar hb; hb.slots = hslots; hb.w = w8 & 3; hb.gen = 0u; *(volatile LAS unsigned*)(hslots + (w8 & 3)) = 0u;
            LDS_BARRIER();
            if (w8 < 4) {
                __builtin_amdgcn_s_setprio(HALF_A_PRIO);
                for (int ra = 0; ra < HREP_G1; ++ra) for (int it = C.wg; it < 1024; it += C.G) { PH_BEGIN(); g1h_chunk(Cp, tidp & 255, l, G1_ITEM(it), lds, hb); }
                for (int ra = 0; ra < HREP_KM; ++ra) for (int it = C.wg; it < 256; it += C.G) { PH_BEGIN(); km4_item(Cp, tidp & 255, it, lds, hb); }
                for (int ra = 0; ra < HREP_SCV; ++ra) { PH_BEGIN(); scv4_all(Cp, tidp & 255, l); }
                for (int it = GS_SPLIT + C.wg; it < 512; it += C.G) { PH_BEGIN(); gs4_item(Cp, tidp & 255, l, it, lds, hb); }
                __builtin_amdgcn_s_setprio(0);
            } else {
                for (int rb = 0; rb < HREP_MS; ++rb) for (int it = C.wg; it < 512; it += C.G) { PH_BEGIN(); ms4_item(Cp, tidp & 255, l, it, lds + H_B, hb); }
                for (int rb = 0; rb < HREP_GS; ++rb) for (int it = C.wg; it < GS_SPLIT; it += C.G) { PH_BEGIN(); gs4_item(Cp, tidp & 255, l, it, lds + H_B, hb); }
            }
        }
        SEAM(base + 3);
        if (PHEN(4) && IN(base + 4)) { for (int rep = 0; rep < REP[8]; ++rep) { const int xcd_ = C.wg & 7, idx_ = C.wg >> 3;
              if (C.G == 256) { if (idx_ < 16) { PH_BEGIN(); g2_scan(Cp, tidp, l, (4 * xcd_ + (idx_ >> 2)) * 4 + (idx_ & 3), lds); } }
              else for (int it = C.wg; it < 128; it += C.G) { PH_BEGIN(); g2_scan(Cp, tidp, l, it, lds); } } }
        if (PHEN(5) && IN(base + 4)) {
            if (C.G == 256 && l == 1) {
                const int x_ = C.wg & 7, idx_ = C.wg >> 3;
                for (int rep = 0; rep < REP[9]; ++rep) {
                    if (idx_ < 16) { PH_BEGIN(); moba_prompt_item(Cp, tidp, 4 * x_ + (idx_ >> 2), 6 + (idx_ & 3), lds); }
                    else {
                        const int i2 = idx_ - 16, t_ = i2 & 3;
                        const int packed = (t_ == 0) ? (15 | (5 << 4) | (2 << 8)) : (t_ == 1) ? (14 | (4 << 4) | (3 << 8)) : (t_ == 2) ? (13 | (10 << 4) | (0 << 8)) : (12 | (11 << 4) | (1 << 8));
                        for (int k = 0; k < 3; ++k) { PH_BEGIN(); moba_prompt_item(Cp, tidp, 4 * x_ + (i2 >> 2), (packed >> (4 * k)) & 15, lds); }
                    }
                }
            } else
            for (int rep = 0; rep < REP[9]; ++rep) for (int it = C.wg; it < 512; it += C.G) {
                const int v_ = (C.G == 256) ? ((it & 7) * 32 + ((it & 255) >> 3)) : (it & 255); const int bh = v_ >> 3, qq = v_ & 7; PH_BEGIN(); moba_prompt_item(Cp, tidp, bh, (it < 256) ? qq : 15 - qq, lds); }
        }
        if (PHEN(5) && IN(base + 4) && l == 0 && conv_deferred(C) && (C.wg >> 3) >= 16) { PH_BEGIN(); conv_slot_b(Cp, tidp, (Cp.wg & 7) * 16 + (Cp.wg >> 3) - 16, 128, lds); }
        SEAM(base + 4);
        if (PHEN(6) && IN(base + 5)) { for (int rep = 0; rep < REP[10]; ++rep) for (int it = C.wg; it < 512; it += C.G) { PH_BEGIN(); g3_pair(Cp, tidp, l, G3_PAIR(it), lds); } }
        SEAM(base + 5);
        if (PHEN(7) && IN(base + 6)) {
            PH_BEGIN();
            pg8::Gemm g{Cp.mix(), (const bf16_t*)(Cp.ws + WS_W + (size_t)l * W_LAYER + WO_OUT), MP, DM, DM}; pg8::StaticOrder S; S.init(MP, DM, Cp.G, Cp.wg);
            for (int rep = 1; rep < REP[13]; ++rep) { pg8::EpiNull EN{Cp.ssq()}; pg8::gemm_phase<pg8::EpiNull, pg8::StaticOrder, true, true>(lds, g, S, EN, tidp); }
            pg8::EpiRES E{Cp.xres(), Cp.xb(), Cp.ssq(), 1.0f};
            pg8::gemm_phase<pg8::EpiRES, pg8::StaticOrder, true, true>(lds, g, S, E, tidp);
            { PH_BEGIN(); sample_gemm_res<DM>(Cp, tidp, Cp.mix() + (size_t)MP * DM, (const bf16_t*)(Cp.ws + WS_W + (size_t)l * W_LAYER + WO_OUT), 1.0f, lds); }
        }
        SEAM(base + 6);
        if (PHEN(8) && IN(base + 7)) {
            PH_BEGIN();
            pg8::Gemm g{Cp.xb(), (const bf16_t*)(Cp.ws + WS_W + (size_t)l * W_LAYER + WO_GU2), MT, NGU, DM}; pg8::StaticOrder S; S.init(MT, NGU, Cp.G, Cp.wg);
            rstd_table(S, Cp.ssq(), lds, tidp); pg8::EpiGU E{(const LAS float*)(lds + RTAB_OFF), Cp.hid()};
            pg8::gemm_phase<pg8::EpiGU, pg8::StaticOrder, true, true>(lds, g, S, E, tidp);
        }
        SEAM(base + 7);
        if (PHEN(9) && IN(base + 8)) {
            PH_BEGIN();
            pg8::Gemm g{Cp.hid(), (const bf16_t*)(Cp.ws + WS_W + (size_t)l * W_LAYER + WO_DN2), MP, DM, FF}; pg8::StaticOrder S; S.init(MP, DM, Cp.G, Cp.wg);
            pg8::EpiRES E{Cp.xres(), Cp.xb(), Cp.ssq(), 0.5f};
            pg8::gemm_phase<pg8::EpiRES, pg8::StaticOrder, true, true>(lds, g, S, E, tidp);
            { PH_BEGIN(); sample_gemm_res<FF>(Cp, tidp, Cp.hid() + (size_t)MP * FF, (const bf16_t*)(Cp.ws + WS_W + (size_t)l * W_LAYER + WO_DN2), 0.5f, lds); }
        }
        SEAM(base + 8);
    }
    if (PHEN(21) && IN(19)) { for (int rep = 0; rep < REP[11]; ++rep) { PH_BEGIN(); final_norm(Cp, tidp); } }
#undef IN
#undef SEAM
}

extern "C" void kernel_launch(void* const* d_in, const int* in_sizes, int n_in, void* d_out, int out_size, void* d_ws, size_t ws_size, hipStream_t stream) {
    static int grid = 0;
    if (grid == 0) {
        if (n_in != 25 || (size_t)out_size != O_END || ws_size < WS_END) { fprintf(stderr, "kernel_launch: unexpected shapes (n_in %d, out %d, ws %zu)\n", n_in, out_size, ws_size); grid = -1; return; }
        int dev = 0, cus = 0, per_cu = 0;
        if (hipGetDevice(&dev) != hipSuccess || hipDeviceGetAttribute(&cus, hipDeviceAttributeMultiprocessorCount, dev) != hipSuccess) { grid = -1; return; }
        if (hipFuncSetAttribute((const void*)mk_fwd, hipFuncAttributeMaxDynamicSharedMemorySize, LDS_BYTES) != hipSuccess) { fprintf(stderr, "kernel_launch: hipFuncSetAttribute failed\n"); grid = -1; return; }
        if (hipOccupancyMaxActiveBlocksPerMultiprocessor(&per_cu, (const void*)mk_fwd, 512, LDS_BYTES) != hipSuccess || per_cu < 1)
            fprintf(stderr, "kernel_launch: occupancy query reports %d workgroups per CU\n", per_cu);
        (void)hipGetLastError();
        grid = cus;
    }
    if (grid < 0) return;
    (void)hipMemsetAsync((char*)d_ws + WS_CTL, 0, CTL_ZERO_BYTES, stream);
    Params a{};
    for (int i = 0; i < 25; ++i) a.in[i] = d_in[i];
    a.out = (float*)d_out; a.ws = (unsigned char*)d_ws;
#if MK_ONE_LAUNCH
    a.ph_lo = 0; a.ph_hi = N_PHASES;
    hipLaunchKernelGGL(mk_fwd, dim3(grid), dim3(512), LDS_BYTES, stream, a);
#else
    for (int ph = 0; ph < N_PHASES; ++ph) { a.ph_lo = ph; a.ph_hi = ph + 1; hipLaunchKernelGGL(mk_fwd, dim3(grid), dim3(512), LDS_BYTES, stream, a); }
#endif
}
```

```cpp
#include <hip/hip_runtime.h>
#include <cstdio>
#include <cstdint>

#ifndef MK_ONE_LAUNCH
#define MK_ONE_LAUNCH 1
#define HREPS 1,1,1,1,1
#endif

#define LAS __attribute__((address_space(3)))
#define GAS __attribute__((address_space(1)))
typedef unsigned short bf16_t;
typedef short bf16x8 __attribute__((ext_vector_type(8)));
typedef short s16x4 __attribute__((ext_vector_type(4)));
typedef float f32x4 __attribute__((ext_vector_type(4)));
typedef float f32x2 __attribute__((ext_vector_type(2)));
typedef unsigned u32x4 __attribute__((ext_vector_type(4)));
typedef unsigned u32x2 __attribute__((ext_vector_type(2)));

constexpr int DM = 1024, MP = 16384, MS = 512, MT = MP + MS, SEQ = 2048;
constexpr int FF = 2816, NGU = 2 * FF, NIN = 3584, PROJ = 3592;
constexpr int NPOOL = 2560, NPAGES = 16;
constexpr float EPS = 1e-6f;
constexpr size_t O_YP = 0, O_YS = 16777216, O_PGDN = 17301504, O_PCONV = 18350080, O_PSCONV = 18423808, O_PK = 18432000, O_PV = 26820608,
                 O_SGDN = 35209216, O_SCONV = 51986432, O_SSCONV = 53166080, O_SK = 53297152, O_SV = 53559296, O_END = 53821440;
constexpr size_t MiB = 1u << 20;
constexpr size_t WS_CTL = 0, CTL_ZERO_BYTES = 65536;
constexpr size_t WS_W = 1 * MiB, W_LAYER = 42 * MiB;
constexpr size_t WO_GU1 = 0, WO_DN1 = 11 * MiB, WO_IN = 16 * MiB + MiB / 2, WO_OUT = 23 * MiB + MiB / 2, WO_GU2 = 25 * MiB + MiB / 2, WO_DN2 = 36 * MiB + MiB / 2;
constexpr size_t WS_WBA = 85 * MiB, WS_XRES = 86 * MiB, WS_XB = 152 * MiB, WS_SSQ = 185 * MiB, WS_HID = 187 * MiB, WS_GQKV = 278 * MiB, WS_GZ = 328 * MiB,
                 WS_SC = 345 * MiB, WS_MQ = 370 * MiB, WS_MK = 379 * MiB, WS_MV = 388 * MiB, WS_BA = 397 * MiB, WS_MIX = 398 * MiB, WS_KM = 431 * MiB,
                 WS_GW = 432 * MiB, WS_GU = 448 * MiB, WS_GATT = 480 * MiB, WS_GQD = 488 * MiB, WS_GAP = 504 * MiB, WS_GBC = 536 * MiB, WS_GCD = 600 * MiB,
                 WS_GST = 601 * MiB, WS_END = 633 * MiB;
constexpr int CW_BAR = 4096;
constexpr int LDS_BYTES = 163840, MISC_OFF = 163840 - 512;

__device__ __forceinline__ float bf2f(unsigned b) { return __uint_as_float(b << 16); }
__device__ __forceinline__ unsigned f2bf(float f) { unsigned u = __float_as_uint(f); return (u + 0x7fffu + ((u >> 16) & 1u)) >> 16; }
typedef __bf16 bf16x2_t __attribute__((ext_vector_type(2)));
__device__ __forceinline__ unsigned pk2(float lo, float hi) { const f32x2 v = {lo, hi}; return __builtin_bit_cast(unsigned, __builtin_convertvector(v, bf16x2_t)); }
__device__ __forceinline__ float wave_sum(float v) {
#pragma unroll
    for (int o = 1; o < 64; o <<= 1) v += __shfl_xor(v, o);
    return v;
}
__device__ __forceinline__ float wave_max(float v) {
#pragma unroll
    for (int o = 1; o < 64; o <<= 1) v = fmaxf(v, __shfl_xor(v, o));
    return v;
}
__device__ __forceinline__ float silu_f(float x) { return x * __builtin_amdgcn_rcpf(1.0f + __expf(-x)); }
#define LDS_BARRIER() do { asm volatile("s_waitcnt lgkmcnt(0)" ::: "memory"); __builtin_amdgcn_s_barrier(); asm volatile("" ::: "memory"); } while (0)
namespace pg8 {
#define PG8_LAS __attribute__((address_space(3)))
typedef unsigned short bf16_t;
typedef short bf16x8 __attribute__((ext_vector_type(8)));
typedef float f32x4 __attribute__((ext_vector_type(4)));
typedef unsigned u32x4 __attribute__((ext_vector_type(4)));
constexpr int BM = 256, BK = 64, HALF = 128, HTB = HALF * BK * 2  , STAGE_BYTES = 8 * HTB, NXCD = 8, WGM = 8;

__host__ __device__ __forceinline__ int lds_byte(int r, int c) { const int st = (r >> 4) * 2 + (c >> 5), rr = r & 15, cc = c & 31, ob = rr * 64 + cc * 2; return st * 1024 + (ob ^ (((ob >> 9) & 1) << 5)); }
__host__ __device__ __forceinline__ void stage_rc(int b, int& R, int& C) { const int st = b / 1024, sb = b % 1024, swz = sb ^ (((sb >> 9) & 1) << 5); R = (st >> 1) * 16 + swz / 64; C = (st & 1) * 32 + (swz % 64) / 2; }
__host__ __device__ __forceinline__ int perm32(int rho) { const int n = rho >> 4, i = rho & 15; return 8 * (i >> 2) + 4 * n + (i & 3); }

struct Unit { int pm, pn; };
struct Gemm { const bf16_t* A; const bf16_t* Bt; int M, N, K; };

struct StaticOrder {
    int nM, nN, nwg, G, c;
    __host__ __device__ void init(int M, int N, int G_, int c_) { nM = M / BM; nN = N / BM; nwg = nM * nN; G = G_; c = c_; }
    __host__ __device__ bool next(int i, Unit& u) const {
        const long L = (long)i * G + c; if (L >= nwg) return false;
        int wgid = (int)L; { const int q = nwg / NXCD, r = nwg % NXCD, xcd = wgid % NXCD, off = wgid / NXCD; wgid = (xcd < r ? xcd * (q + 1) : r * (q + 1) + (xcd - r) * q) + off; }
        const int nig = WGM * nN, gid = wgid / nig, fm = gid * WGM, gsz = (nM - fm) < WGM ? (nM - fm) : WGM;
        u.pm = fm + ((wgid % nig) % gsz); u.pn = (wgid % nig) / gsz; return true;
    }
    __device__ __forceinline__ void a_ready(const Unit&) const {}
    __device__ __forceinline__ void done(const Unit&) const {}
};

__device__ __forceinline__ unsigned cvt_pk_bf16(float lo, float hi) { return pk2(lo, hi); }
typedef float f32x2 __attribute__((ext_vector_type(2)));
template <class Epi, class Sched, bool ALIGN_EPI = false, bool SP2 = false>
__device__ __forceinline__ void gemm_phase(PG8_LAS unsigned char* lds, const Gemm g, const Sched& S, const Epi& E, const int tid_in) {
    const int tid = tid_in, wid = __builtin_amdgcn_readfirstlane(tid >> 6), lane = tid & 63, wr = wid >> 2, wc = wid & 3, fr = lane & 15, fq = lane >> 4;
    const int K = g.K, nt = K / BK;
    unsigned voffA[2], voffB[2];
#pragma unroll
    for (int i = 0; i < 2; ++i) { int R, C; stage_rc(tid * 16 + i * 8192, R, C); const int Rb = Epi::PERM ? ((R & ~31) + perm32(R & 31)) : R;
        voffA[i] = (unsigned)(R * K + C) * 2u; voffB[i] = (unsigned)(Rb * K + C) * 2u; }
    const size_t kstep = (size_t)(BK * 2);
    const size_t hstep = (size_t)HALF * K * 2;
    const size_t tstep = 2 * hstep;
    const unsigned ldsw = (unsigned)wid * 1024u;
    const int aoff = lds_byte(wr * 64 + fr, fq * 8), boff = lds_byte(wc * 32 + fr, fq * 8);
#define PG8_SA(b, h) (((b) * 2 + (h)) * HTB)
#define PG8_SB(b, h) ((4 + (b) * 2 + (h)) * HTB)
#define PG8_STAGE(bufoff, gbase, voff) do { _Pragma("unroll") for (int _i = 0; _i < 2; ++_i) \
        __builtin_amdgcn_global_load_lds((const unsigned*)((const char*)(gbase) + (voff)[_i]), (PG8_LAS unsigned*)(lds + (bufoff) + ldsw + _i * 8192), 16, 0, 0); } while (0)
#define PG8_LDA(dst, b, h) do { _Pragma("unroll") for (int m = 0; m < 4; ++m) _Pragma("unroll") for (int k = 0; k < 2; ++k) dst[m][k] = *(const PG8_LAS bf16x8*)(lds + PG8_SA(b, h) + aoff + m * 2048 + k * 1024); } while (0)
#define PG8_LDB(dst, b, h) do { _Pragma("unroll") for (int n = 0; n < 2; ++n) _Pragma("unroll") for (int k = 0; k < 2; ++k) dst[n][k] = *(const PG8_LAS bf16x8*)(lds + PG8_SB(b, h) + boff + n * 2048 + k * 1024); } while (0)
#define PG8_MMA(ai, bj, At, Bt) do { __builtin_amdgcn_s_setprio(1); _Pragma("unroll") for (int m = 0; m < 4; ++m) _Pragma("unroll") for (int n = 0; n < 2; ++n) _Pragma("unroll") for (int k = 0; k < 2; ++k) \
        acc[ai][bj][m][n] = __builtin_amdgcn_mfma_f32_16x16x32_bf16(Bt[n][k], At[m][k], acc[ai][bj][m][n], 0, 0, 0); __builtin_amdgcn_s_setprio(0); } while (0)
#define PG8_WAIT_V(n) asm volatile("s_waitcnt vmcnt(" #n ")" ::: "memory")
#define PG8_WAIT_L(n) asm volatile("s_waitcnt lgkmcnt(" #n ")" ::: "memory")
#define PG8_BAR __builtin_amdgcn_s_barrier()
#define PG8_SCHED __builtin_amdgcn_sched_barrier(0)
    Unit cur, nxt; int ui = 0;
    if (!S.next(0, cur)) return;
    f32x4 acc[2][2][4][2];
#pragma unroll
    for (int a = 0; a < 2; ++a)
#pragma unroll
        for (int b = 0; b < 2; ++b)
#pragma unroll
            for (int m = 0; m < 4; ++m)
#pragma unroll
                for (int n = 0; n < 2; ++n) acc[a][b][m][n] = (f32x4){0.f, 0.f, 0.f, 0.f};
    bf16x8 At[4][2], B0[2][2], B1[2][2];
    const char* cA = (const char*)g.A + (size_t)cur.pm * tstep; const char* cB = (const char*)g.Bt + (size_t)cur.pn * tstep;
    S.a_ready(cur);
    if constexpr (SP2) {
        PG8_STAGE(PG8_SB(0, 0), cB, voffB); PG8_STAGE(PG8_SB(0, 1), cB + hstep, voffB); PG8_STAGE(PG8_SA(0, 0), cA, voffA); PG8_STAGE(PG8_SA(0, 1), cA + hstep, voffA);
        if (wr == 1) PG8_BAR;
        PG8_WAIT_V(2); PG8_BAR;
        PG8_STAGE(PG8_SB(1, 0), cB + kstep, voffB); PG8_STAGE(PG8_SA(1, 0), cA + kstep, voffA); PG8_STAGE(PG8_SB(1, 1), cB + hstep + kstep, voffB);
        PG8_WAIT_V(6); PG8_BAR;
    } else {
        PG8_STAGE(PG8_SB(0, 0), cB, voffB); PG8_STAGE(PG8_SA(0, 0), cA, voffA); PG8_STAGE(PG8_SB(0, 1), cB + hstep, voffB); PG8_STAGE(PG8_SA(0, 1), cA + hstep, voffA);
        if (wr == 1) PG8_BAR;
        PG8_WAIT_V(4); PG8_BAR;
        PG8_STAGE(PG8_SB(1, 0), cB + kstep, voffB); PG8_STAGE(PG8_SA(1, 0), cA + kstep, voffA); PG8_STAGE(PG8_SB(1, 1), cB + hstep + kstep, voffB);
        PG8_WAIT_V(6); PG8_BAR;
    }
    for (;;) {
        const bool has_next = S.next(ui + 1, nxt);
        const char* nA = has_next ? (const char*)g.A + (size_t)nxt.pm * tstep : cA; const char* nB = has_next ? (const char*)g.Bt + (size_t)nxt.pn * tstep : cB;
        for (int t = 0; t < nt; t += 2) {
            const bool last = (t == nt - 2);
            const char* a1 = cA + (size_t)(t + 1) * kstep;
            const char* a2 = last ? nA : cA + (size_t)(t + 2) * kstep; const char* b2 = last ? nB : cB + (size_t)(t + 2) * kstep;
            const char* a3 = a2 + kstep; const char* b3 = b2 + kstep;
            if (last && has_next) S.a_ready(nxt);
            if constexpr (SP2) {
            PG8_LDB(B0, 0, 0); PG8_LDB(B1, 0, 1); PG8_SCHED; PG8_LDA(At, 0, 0); PG8_STAGE(PG8_SA(1, 1), a1 + hstep, voffA);
            PG8_WAIT_V(8); PG8_WAIT_L(0); PG8_BAR; PG8_MMA(0, 0, At, B0); PG8_MMA(0, 1, At, B1); PG8_BAR; PG8_SCHED;
            PG8_LDA(At, 0, 1); PG8_STAGE(PG8_SB(0, 0), b2, voffB); PG8_STAGE(PG8_SB(0, 1), b2 + hstep, voffB); PG8_STAGE(PG8_SA(0, 0), a2, voffA);
            PG8_WAIT_V(8); PG8_WAIT_L(0); PG8_BAR; PG8_MMA(1, 0, At, B0); PG8_MMA(1, 1, At, B1); PG8_BAR; PG8_SCHED;
            PG8_LDB(B0, 1, 0); PG8_LDB(B1, 1, 1); PG8_SCHED; PG8_LDA(At, 1, 0); PG8_STAGE(PG8_SA(0, 1), a2 + hstep, voffA);
            PG8_WAIT_V(8); PG8_WAIT_L(0); PG8_BAR; PG8_MMA(0, 0, At, B0); PG8_MMA(0, 1, At, B1); PG8_BAR; PG8_SCHED;
            PG8_LDA(At, 1, 1); PG8_STAGE(PG8_SB(1, 0), b3, voffB); PG8_STAGE(PG8_SB(1, 1), b3 + hstep, voffB); PG8_STAGE(PG8_SA(1, 0), a3, voffA);
            PG8_WAIT_V(8); PG8_WAIT_L(0); PG8_BAR; PG8_MMA(1, 0, At, B0); PG8_MMA(1, 1, At, B1); PG8_BAR; PG8_SCHED;
            } else {
            PG8_LDB(B0, 0, 0); PG8_SCHED; PG8_LDA(At, 0, 0); PG8_STAGE(PG8_SA(1, 1), a1 + hstep, voffA);
            PG8_WAIT_L(8); PG8_BAR; PG8_WAIT_L(0); PG8_MMA(0, 0, At, B0); PG8_BAR; PG8_SCHED;
            PG8_LDB(B1, 0, 1); PG8_STAGE(PG8_SB(0, 0), b2, voffB);
            PG8_BAR; PG8_WAIT_L(0); PG8_MMA(0, 1, At, B1); PG8_BAR;
            PG8_LDA(At, 0, 1); PG8_STAGE(PG8_SA(0, 0), a2, voffA);
            PG8_BAR; PG8_WAIT_L(0); PG8_MMA(1, 0, At, B0); PG8_BAR; PG8_SCHED;
            PG8_STAGE(PG8_SB(0, 1), b2 + hstep, voffB);
            PG8_WAIT_V(6); PG8_BAR; PG8_MMA(1, 1, At, B1); PG8_BAR;
            PG8_LDB(B0, 1, 0); PG8_SCHED; PG8_LDA(At, 1, 0); PG8_STAGE(PG8_SA(0, 1), a2 + hstep, voffA);
            PG8_WAIT_L(8); PG8_BAR; PG8_WAIT_L(0); PG8_MMA(0, 0, At, B0); PG8_BAR; PG8_SCHED;
            PG8_LDB(B1, 1, 1); PG8_STAGE(PG8_SB(1, 0), b3, voffB);
            PG8_BAR; PG8_WAIT_L(0); PG8_MMA(0, 1, At, B1); PG8_BAR;
            PG8_LDA(At, 1, 1); PG8_STAGE(PG8_SA(1, 0), a3, voffA);
            PG8_BAR; PG8_WAIT_L(0); PG8_MMA(1, 0, At, B0); PG8_BAR; PG8_SCHED;
            PG8_STAGE(PG8_SB(1, 1), b3 + hstep, voffB);
            PG8_WAIT_V(6); PG8_BAR; PG8_MMA(1, 1, At, B1); PG8_BAR;
            }
        }
        if constexpr (ALIGN_EPI) { if (wr == 0) PG8_BAR; }
        if constexpr (!Epi::AFTER_DRAIN) { E(acc, cur, wr, wc, fr, fq, ui); S.done(cur); }
        if (!has_next) break;
#pragma unroll
        for (int a = 0; a < 2; ++a)
#pragma unroll
            for (int b = 0; b < 2; ++b)
#pragma unroll
                for (int m = 0; m < 4; ++m)
#pragma unroll
                    for (int n = 0; n < 2; ++n) acc[a][b][m][n] = (f32x4){0.f, 0.f, 0.f, 0.f};
        cur = nxt; cA = nA; cB = nB; ++ui;
        if constexpr (ALIGN_EPI) { if (wr == 1) PG8_BAR; }
    }
    PG8_WAIT_V(0);
    if constexpr (!ALIGN_EPI) { if (wr == 0) PG8_BAR; }
    PG8_BAR;
    if constexpr (Epi::AFTER_DRAIN) { E.fused(acc, cur, wr, wc, fr, fq, lds, wid, lane); S.done(cur); }
#undef PG8_SA
#undef PG8_SB
#undef PG8_STAGE
#undef PG8_LDA
#undef PG8_LDB
#undef PG8_MMA
#undef PG8_WAIT_V
#undef PG8_WAIT_L
#undef PG8_BAR
#undef PG8_SCHED
}
}
#define XB_TMO      128
#define XB_XCNT(j)  (256  + 64 * (j))
#define XB_XSUB(j)  (1280 + 64 * (j))
#define XB_XGEN(j)  (2304 + 64 * (j))
#define XB_TOP      3328
#define XB_TOPGEN   3392
#define XCD_BAR_WORDS 3456
#define XB_SPIN_CAP (1u << 18)

__device__ __forceinline__ unsigned xb_ld(unsigned* p)              { return __hip_atomic_load(p, __ATOMIC_RELAXED, __HIP_MEMORY_SCOPE_AGENT); }
__device__ __forceinline__ unsigned xb_add(unsigned* p, unsigned v) { return __hip_atomic_fetch_add(p, v, __ATOMIC_RELAXED, __HIP_MEMORY_SCOPE_AGENT); }
__device__ __forceinline__ unsigned xb_xcc_id() { return (unsigned)__builtin_amdgcn_s_getreg((3 << 11) | 20) & 0xFu; }
#define XB_SPIN(cond, bar) do { unsigned _sp = 0; while (cond) { __builtin_amdgcn_s_sleep(1); \
    if ((++_sp & 255u) == 0u) { if (xb_ld(&(bar)[XB_TMO])) break; if (_sp > XB_SPIN_CAP) { atomicAdd(&(bar)[XB_TMO], 1u); break; } } } } while (0)

struct XcdBarrier {
    unsigned* bar; unsigned x;
    volatile LAS unsigned* st;
};

__device__ __forceinline__ XcdBarrier xcd_barrier_post(unsigned* bar, volatile LAS unsigned* st) {
    XcdBarrier b; b.bar = bar; b.x = xb_xcc_id(); b.st = st;
    if (threadIdx.x == 0) (void)xb_add(&bar[XB_XCNT(b.x)], 1u);
    return b;
}
__device__ __forceinline__ void xcd_barrier_complete(unsigned* bar, unsigned x, unsigned& nloc, unsigned& nx) {
    const unsigned G = gridDim.x * gridDim.y * gridDim.z;
    unsigned sum, cnt, mine, sp = 0u;
    for (;;) {
        sum = 0u; cnt = 0u; mine = 0u;
#pragma unroll
        for (unsigned j = 0; j < 16; ++j) { const unsigned c = xb_ld(&bar[XB_XCNT(j)]); sum += c; cnt += (c > 0u) ? 1u : 0u; mine = (j == x) ? c : mine; }
        if (sum == G) break;
        __builtin_amdgcn_s_sleep(1);
        if ((++sp & 255u) == 0u) { if (xb_ld(&bar[XB_TMO])) break; if (sp > XB_SPIN_CAP) { atomicAdd(&bar[XB_TMO], 1u); break; } }
    }
    nloc = mine > 0u ? mine : 1u; nx = cnt > 0u ? cnt : 1u;
}

__device__ __forceinline__ void xcd_barrier(const XcdBarrier& b) {
    asm volatile("s_waitcnt vmcnt(0)" ::: "memory");
    __syncthreads();
    if (threadIdx.x == 0) {
        unsigned* bar = b.bar;
        __builtin_amdgcn_s_waitcnt(0);
        unsigned nloc = b.st[0], nx = b.st[1];
        if (nloc == 0u) { xcd_barrier_complete(bar, b.x, nloc, nx); b.st[0] = nloc; b.st[1] = nx; }
        const unsigned old = xb_add(&bar[XB_XSUB(b.x)], 1u);
        const unsigned gen = old / nloc;
        if (old + 1u == (gen + 1u) * nloc) {
            __builtin_amdgcn_fence(__ATOMIC_RELEASE, "agent");
            asm volatile("s_waitcnt vmcnt(0)" ::: "memory");
            const unsigned og = xb_add(&bar[XB_TOP], 1u);
            const unsigned tg = og / nx;
            if (og + 1u == (tg + 1u) * nx) xb_add(&bar[XB_TOPGEN], 1u);
            else XB_SPIN(xb_ld(&bar[XB_TOPGEN]) == tg, bar);
            __builtin_amdgcn_fence(__ATOMIC_ACQUIRE, "agent");
            xb_add(&bar[XB_XGEN(b.x)], 1u);
            asm volatile("s_waitcnt vmcnt(0)" ::: "memory");
        } else {
            XB_SPIN(xb_ld(&bar[XB_XGEN(b.x)]) == gen, bar);
            __builtin_amdgcn_fence(__ATOMIC_ACQUIRE, "agent");
            asm volatile("s_waitcnt vmcnt(0)" ::: "memory");
        }
    }
    __syncthreads();
}

namespace pg8 {
__device__ __forceinline__ float row_rstd(const float* ssq, int row) {
    const f32x4* p = (const f32x4*)(ssq + (size_t)row * 16);
    const f32x4 a = p[0], b = p[1], c = p[2], d = p[3];
    const float s = ((a[0] + a[1]) + (a[2] + a[3])) + ((b[0] + b[1]) + (b[2] + b[3])) + ((c[0] + c[1]) + (c[2] + c[3])) + ((d[0] + d[1]) + (d[2] + d[3]));
    return __builtin_amdgcn_rsqf(s * (1.0f / 1024.0f) + EPS);
}
struct EpiGU {
    static constexpr bool PERM = true, AFTER_DRAIN = false;
    const LAS float* rtab; bf16_t* hid;
    __device__ __forceinline__ void operator()(const f32x4 (&acc)[2][2][4][2], const Unit& u, int wr, int wc, int fr, int fq, int ui) const {
        asm volatile("" : "+v"(fr), "+v"(fq));
        const int col0 = u.pn * 128 + wc * 32 + 8 * fq;
#pragma unroll
        for (int ai = 0; ai < 2; ++ai)
#pragma unroll
            for (int m = 0; m < 4; ++m) {
                const int row = u.pm * BM + ai * HALF + wr * 64 + m * 16 + fr;
                const float rs = rtab[ui * 256 + ai * HALF + wr * 64 + m * 16 + fr];
                float hv[8];
#pragma unroll
                for (int n = 0; n < 2; ++n)
#pragma unroll
                    for (int i = 0; i < 4; ++i) { const float g = acc[ai][0][m][n][i] * rs, uu = acc[ai][1][m][n][i] * rs; hv[4 * n + i] = silu_f(g) * uu; }
                u32x4 w; w.x = cvt_pk_bf16(hv[0], hv[1]); w.y = cvt_pk_bf16(hv[2], hv[3]); w.z = cvt_pk_bf16(hv[4], hv[5]); w.w = cvt_pk_bf16(hv[6], hv[7]);
                *(u32x4*)(hid + (size_t)row * FF + col0) = w;
            }
    }
};
struct EpiNull {
    static constexpr bool PERM = true, AFTER_DRAIN = false;
    float* sink;
    __device__ __forceinline__ void operator()(const f32x4 (&acc)[2][2][4][2], const Unit& u, int wr, int wc, int fr, int fq, int ui) const {
        float s = 0.f;
#pragma unroll
        for (int ai = 0; ai < 2; ++ai)
#pragma unroll
            for (int bj = 0; bj < 2; ++bj)
#pragma unroll
                for (int m = 0; m < 4; ++m)
#pragma unroll
                    for (int n = 0; n < 2; ++n) s += acc[ai][bj][m][n][0] + acc[ai][bj][m][n][1] + acc[ai][bj][m][n][2] + acc[ai][bj][m][n][3];
        if (s == 1.2345678e33f) sink[0] = s;
    }
};
struct EpiRES {
    static constexpr bool PERM = true, AFTER_DRAIN = false;
    float* xres; bf16_t* xb; float* ssq; float scale;
    __device__ __forceinline__ void operator()(const f32x4 (&acc)[2][2][4][2], const Unit& u, int wr, int wc, int fr, int fq, int ui) const {
        asm volatile("" : "+v"(fr), "+v"(fq));
#pragma unroll
        for (int ai = 0; ai < 2; ++ai)
#pragma unroll
            for (int m = 0; m < 4; ++m) {
                const int row = u.pm * BM + ai * HALF + wr * 64 + m * 16 + fr;
                float ss = 0.f;
#pragma unroll
                for (int bj = 0; bj < 2; ++bj) {
                    const int col = u.pn * BM + bj * HALF + wc * 32 + 8 * fq;
                    bf16_t* xp = xb + (size_t)row * DM + col;
                    const u32x4 xo = *(const u32x4*)xp;
                    f32x4 x0 = {bf2f(xo.x & 0xffffu), bf2f(xo.x >> 16), bf2f(xo.y & 0xffffu), bf2f(xo.y >> 16)}, x1 = {bf2f(xo.z & 0xffffu), bf2f(xo.z >> 16), bf2f(xo.w & 0xffffu), bf2f(xo.w >> 16)};
                    x0 = x0 + acc[ai][bj][m][0] * scale; x1 = x1 + acc[ai][bj][m][1] * scale;
                    u32x4 w; w.x = cvt_pk_bf16(x0[0], x0[1]); w.y = cvt_pk_bf16(x0[2], x0[3]); w.z = cvt_pk_bf16(x1[0], x1[1]); w.w = cvt_pk_bf16(x1[2], x1[3]);
                    *(u32x4*)xp = w;
                    ss += (x0[0] * x0[0] + x0[1] * x0[1]) + (x0[2] * x0[2] + x0[3] * x0[3]) + (x1[0] * x1[0] + x1[1] * x1[1]) + (x1[2] * x1[2] + x1[3] * x1[3]);
                }
                ss += __shfl_xor(ss, 16); ss += __shfl_xor(ss, 32);
                if (fq == 0) ssq[(size_t)row * 16 + 4 * u.pn + wc] = ss;
            }
    }
};
struct EpiIN {
    static constexpr bool PERM = true, AFTER_DRAIN = false;
    unsigned char* ws; float* out; int layer; const LAS float* rtab;
    __device__ __forceinline__ void operator()(const f32x4 (&acc)[2][2][4][2], const Unit& u, int wr, int wc, int fr, int fq, int ui) const {
        asm volatile("" : "+v"(fr), "+v"(fq));
        const int pn = u.pn;
#pragma unroll
        for (int ai = 0; ai < 2; ++ai) {
#pragma unroll
            for (int m = 0; m < 4; ++m) {
                const int row = u.pm * BM + ai * HALF + wr * 64 + m * 16 + fr;
                const float rs = rtab[ui * 256 + ai * HALF + wr * 64 + m * 16 + fr];
                const bool samp = row >= MP;
                const int sr = row - MP;
                const int b = samp ? (sr >> 2) : (row >> 11), t = samp ? (sr & 3) : (row & 2047);
#pragma unroll
                for (int bj = 0; bj < 2; ++bj) {
                    const int cc = bj * HALF + wc * 32 + 8 * fq;
                    f32x4 v0 = acc[ai][bj][m][0] * rs, v1 = acc[ai][bj][m][1] * rs;
                    if (pn == 11) { v0 = v0 * 0.125f; v1 = v1 * 0.125f; }
                    u32x4 w; w.x = cvt_pk_bf16(v0[0], v0[1]); w.y = cvt_pk_bf16(v0[2], v0[3]); w.z = cvt_pk_bf16(v1[0], v1[1]); w.w = cvt_pk_bf16(v1[2], v1[3]);
                    if (pn < 6) {
                        const int col = pn * 256 + cc;
                        *(u32x4*)((bf16_t*)(ws + WS_GQKV) + (size_t)row * 1536 + col) = w;
                        const int j = samp ? (t - 1) : (t - 2045);
                        if (j >= 0) {
                            float* o = out + (samp ? (O_SCONV + ((size_t)(layer * 128 + b) * 3 + j) * 1536) : (O_PCONV + ((size_t)(layer * 8 + b) * 3 + j) * 1536)) + col;
                            *(f32x4*)o = v0; *(f32x4*)(o + 4) = v1;
                        }
                    } else if (pn < 8) {
                        *(u32x4*)((bf16_t*)(ws + WS_GZ) + (size_t)row * 512 + (pn - 6) * 256 + cc) = w;
                    } else if (pn < 11) {
                        *(u32x4*)((bf16_t*)(ws + WS_SC) + (size_t)row * 768 + (pn - 8) * 256 + cc) = w;
                    } else {
                        const int head = cc >> 6, d = cc & 63;
                        const size_t off = samp ? ((size_t)MP * 256 + ((size_t)(b * 4 + head) * 4 + t) * 64 + d) : (((size_t)(b * 4 + head) * 2048 + t) * 64 + d);
                        bf16_t* dst = (bf16_t*)(ws + ((pn == 11) ? WS_MQ : (pn == 12 ? WS_MK : WS_MV)));
                        *(u32x4*)(dst + off) = w;
                        if (pn >= 12) {
                            const size_t ob = (pn == 12) ? (samp ? O_SK : O_PK) : (samp ? O_SV : O_PV);
                            float* o = out + ob + (samp ? ((size_t)(layer * 128 + b) * 4 + t) * 256 : ((size_t)(layer * 8 + b) * 2048 + t) * 256) + cc;
                            *(f32x4*)o = v0; *(f32x4*)(o + 4) = v1;
                        }
                    }
                }
            }
        }
    }
};
}

constexpr int RTAB_OFF = 131072 + 1024;
template <class Sched> __device__ __forceinline__ void rstd_table(const Sched& S, const float* ssq, LAS unsigned char* lds, const int tid) {
    LAS float* tab = (LAS float*)(lds + RTAB_OFF);
    pg8::Unit u;
    for (int i = 0; i < 6 && S.next(i, u); ++i) if (tid < 256) tab[i * 256 + tid] = pg8::row_rstd(ssq, u.pm * 256 + tid);
    LDS_BARRIER();
}

struct Params { const void* in[25]; float* out; unsigned char* ws; int ph_lo, ph_hi; };

struct Ctx {
    const __attribute__((address_space(4))) Params* P; unsigned char* ws; float* out; int G, wg;
    __device__ __forceinline__ const float* x_prompt() const { return (const float*)(const GAS float*)P->in[0]; }
    __device__ __forceinline__ const float* x_sample() const { return (const float*)(const GAS float*)P->in[1]; }
    __device__ __forceinline__ const float* state_gdn() const { return (const float*)(const GAS float*)P->in[2]; }
    __device__ __forceinline__ const float* state_gdn_conv() const { return (const float*)(const GAS float*)P->in[3]; }
    __device__ __forceinline__ const float* state_sconv() const { return (const float*)(const GAS float*)P->in[4]; }
    __device__ __forceinline__ const float* cache_k() const { return (const float*)(const GAS float*)P->in[5]; }
    __device__ __forceinline__ const float* cache_v() const { return (const float*)(const GAS float*)P->in[6]; }
    __device__ __forceinline__ const int* page_table() const { return (const int*)(const GAS int*)P->in[7]; }
    __device__ __forceinline__ const float* norm_ffn1() const { return (const float*)(const GAS float*)P->in[8]; }
    __device__ __forceinline__ const float* ffn1_w_gate() const { return (const float*)(const GAS float*)P->in[9]; }
    __device__ __forceinline__ const float* ffn1_w_up() const { return (const float*)(const GAS float*)P->in[10]; }
    __device__ __forceinline__ const float* ffn1_w_down() const { return (const float*)(const GAS float*)P->in[11]; }
    __device__ __forceinline__ const float* norm_mix() const { return (const float*)(const GAS float*)P->in[12]; }
    __device__ __forceinline__ const float* w_in() const { return (const float*)(const GAS float*)P->in[13]; }
    __device__ __forceinline__ const float* gdn_conv_w() const { return (const float*)(const GAS float*)P->in[14]; }
    __device__ __forceinline__ const float* gdn_a_log() const { return (const float*)(const GAS float*)P->in[15]; }
    __device__ __forceinline__ const float* gdn_dt_bias() const { return (const float*)(const GAS float*)P->in[16]; }
    __device__ __forceinline__ const float* gdn_norm_w() const { return (const float*)(const GAS float*)P->in[17]; }
    __device__ __forceinline__ const float* sc_conv_w() const { return (const float*)(const GAS float*)P->in[18]; }
    __device__ __forceinline__ const float* w_out() const { return (const float*)(const GAS float*)P->in[19]; }
    __device__ __forceinline__ const float* norm_ffn2() const { return (const float*)(const GAS float*)P->in[20]; }
    __device__ __forceinline__ const float* ffn2_w_gate() const { return (const float*)(const GAS float*)P->in[21]; }
    __device__ __forceinline__ const float* ffn2_w_up() const { return (const float*)(const GAS float*)P->in[22]; }
    __device__ __forceinline__ const float* ffn2_w_down() const { return (const float*)(const GAS float*)P->in[23]; }
    __device__ __forceinline__ const float* norm_final() const { return (const float*)(const GAS float*)P->in[24]; }
    __device__ __forceinline__ float* wba() const { return (float*)(ws + WS_WBA); }
    __device__ __forceinline__ float* xres() const { return (float*)(ws + WS_XRES); }
    __device__ __forceinline__ float* ssq() const { return (float*)(ws + WS_SSQ); }
    __device__ __forceinline__ float* ba() const { return (float*)(ws + WS_BA); }
    __device__ __forceinline__ float* gu() const { return (float*)(ws + WS_GU); }
    __device__ __forceinline__ float* gbc() const { return (float*)(ws + WS_GBC); }
    __device__ __forceinline__ float* gcd() const { return (float*)(ws + WS_GCD); }
    __device__ __forceinline__ bf16_t* xb() const { return (bf16_t*)(ws + WS_XB); }
    __device__ __forceinline__ bf16_t* hid() const { return (bf16_t*)(ws + WS_HID); }
    __device__ __forceinline__ bf16_t* gqkv() const { return (bf16_t*)(ws + WS_GQKV); }
    __device__ __forceinline__ bf16_t* gz() const { return (bf16_t*)(ws + WS_GZ); }
    __device__ __forceinline__ bf16_t* sc() const { return (bf16_t*)(ws + WS_SC); }
    __device__ __forceinline__ bf16_t* mq() const { return (bf16_t*)(ws + WS_MQ); }
    __device__ __forceinline__ bf16_t* mk() const { return (bf16_t*)(ws + WS_MK); }
    __device__ __forceinline__ bf16_t* mv() const { return (bf16_t*)(ws + WS_MV); }
    __device__ __forceinline__ bf16_t* mix() const { return (bf16_t*)(ws + WS_MIX); }
    __device__ __forceinline__ bf16_t* km() const { return (bf16_t*)(ws + WS_KM); }
    __device__ __forceinline__ bf16_t* gw() const { return (bf16_t*)(ws + WS_GW); }
    __device__ __forceinline__ bf16_t* gatt() const { return (bf16_t*)(ws + WS_GATT); }
    __device__ __forceinline__ bf16_t* gqd() const { return (bf16_t*)(ws + WS_GQD); }
    __device__ __forceinline__ bf16_t* gap() const { return (bf16_t*)(ws + WS_GAP); }
    __device__ __forceinline__ bf16_t* gst() const { return (bf16_t*)(ws + WS_GST); }
};

__device__ __forceinline__ bf16x8 tr_frag(const LAS unsigned char* img, int stride_bytes, int row0, int row1, int col0, int lane) {
    const int q = (lane & 15) >> 2, p = lane & 3;
    const s16x4 lo = __builtin_amdgcn_ds_read_tr16_b64_v4i16((LAS s16x4*)(img + (row0 + q) * stride_bytes + (col0 + 4 * p) * 2));
    const s16x4 hi = __builtin_amdgcn_ds_read_tr16_b64_v4i16((LAS s16x4*)(img + (row1 + q) * stride_bytes + (col0 + 4 * p) * 2));
    bf16x8 r; r[0] = lo[0]; r[1] = lo[1]; r[2] = lo[2]; r[3] = lo[3]; r[4] = hi[0]; r[5] = hi[1]; r[6] = hi[2]; r[7] = hi[3];
    return r;
}
#define MFMA16(a, b, c) __builtin_amdgcn_mfma_f32_16x16x32_bf16((a), (b), (c), 0, 0, 0)

#ifndef SG_DEPTH
#define SG_DEPTH 6
#endif
template <int K>
__device__ __forceinline__ void sample_gemm_res(const Ctx& C, const int tid0, const bf16_t* A, const bf16_t* Bt, const float scale, LAS unsigned char* lds) {
    const int tid = tid0, lane = tid & 63, w = tid >> 6, g4 = lane >> 4, l15 = lane & 15;
    LAS f32x4* part = (LAS f32x4*)lds;
    LAS float* ssp = (LAS float*)(lds + 65536);
    constexpr int KW = K / 8, NKS = KW / 32, D = NKS < SG_DEPTH ? NKS : SG_DEPTH;
    for (int pr = C.wg; pr < 256; pr += C.G) {
        const int rt2 = pr >> 4, cg = pr & 15;
        const bf16_t* ap = A + (size_t)(32 * rt2 + l15) * K + w * KW + 8 * g4;
        const bf16_t* bp = Bt + (size_t)(64 * cg + l15) * K + w * KW + 8 * g4;
        f32x4 acc[2][4];
#pragma unroll
        for (int i = 0; i < 2; ++i)
#pragma unroll
            for (int t = 0; t < 4; ++t) acc[i][t] = (f32x4){0.f, 0.f, 0.f, 0.f};
        bf16x8 a[D][2], bb[D][4];
#define SG_LOAD(sl_, ks_) do { _Pragma("unroll") for (int i = 0; i < 2; ++i) a[sl_][i] = *(const bf16x8*)(ap + (size_t)(16 * i) * K + 32 * (ks_)); \
                               _Pragma("unroll") for (int t = 0; t < 4; ++t) bb[sl_][t] = *(const bf16x8*)(bp + (size_t)(16 * t) * K + 32 * (ks_)); } while (0)
#pragma unroll
        for (int s_ = 0; s_ < D; ++s_) SG_LOAD(s_, s_);
#pragma unroll
        for (int ks = 0; ks < NKS; ++ks) {
            const int sl = ks % D;
#pragma unroll
            for (int i = 0; i < 2; ++i)
#pragma unroll
                for (int t = 0; t < 4; ++t) acc[i][t] = MFMA16(a[sl][i], bb[sl][t], acc[i][t]);
            if (ks + D < NKS) SG_LOAD(sl, ks + D);
        }
#undef SG_LOAD
#pragma unroll
        for (int i = 0; i < 2; ++i)
#pragma unroll
            for (int t = 0; t < 4; ++t) part[((w * 8) + i * 4 + t) * 64 + lane] = acc[i][t];
        LDS_BARRIER();
        f32x4 s = part[(0 * 8 + w) * 64 + lane];
#pragma unroll
        for (int q = 1; q < 8; ++q) s = s + part[(q * 8 + w) * 64 + lane];
        const int rti = w >> 2, ct = w & 3, col = 64 * cg + 16 * ct + l15;
#pragma unroll
        for (int r = 0; r < 4; ++r) {
            const size_t row = (size_t)MP + 32 * rt2 + 16 * rti + 4 * g4 + r;
            const float x = bf2f(C.xb()[row * DM + col]) + scale * s[r];
            C.xb()[row * DM + col] = (bf16_t)f2bf(x);
            float ss = x * x;
            ss += __shfl_xor(ss, 1); ss += __shfl_xor(ss, 2); ss += __shfl_xor(ss, 4); ss += __shfl_xor(ss, 8);
            if (l15 == 0) ssp[w * 16 + 4 * g4 + r] = ss;
        }
        LDS_BARRIER();
        if (ct == 0 && lane < 16)
            C.ssq()[((size_t)MP + 32 * rt2 + 16 * rti + lane) * 16 + cg] = (ssp[(rti * 4 + 0) * 16 + lane] + ssp[(rti * 4 + 1) * 16 + lane]) + (ssp[(rti * 4 + 2) * 16 + lane] + ssp[(rti * 4 + 3) * 16 + lane]);
        LDS_BARRIER();
    }
}

__device__ __forceinline__ void tr_item(const float* W, int ldw, int c0, const float* gain, bf16_t* WT, int K, int n0, int k0, LAS float* scr, int lane) {
    float v[32];
#pragma unroll
    for (int i = 0; i < 32; ++i) v[i] = W[(size_t)(k0 + 2 * i + (lane >> 5)) * ldw + c0 + (lane & 31)];
#pragma unroll
    for (int i = 0; i < 32; ++i) scr[(2 * i + (lane >> 5)) * 33 + (lane & 31)] = v[i];
    asm volatile("s_waitcnt lgkmcnt(0)" ::: "memory");
    const int c = lane & 7;
    f32x4 g0 = {1.f, 1.f, 1.f, 1.f}, g1 = {1.f, 1.f, 1.f, 1.f};
    if (gain) { g0 = *(const f32x4*)(gain + k0 + 8 * c); g1 = *(const f32x4*)(gain + k0 + 8 * c + 4); }
#pragma unroll
    for (int j = 0; j < 4; ++j) { const int n = (lane >> 3) + 8 * j; const LAS float* s = scr + (8 * c) * 33 + n;
        u32x4 o; o.x = pk2(s[0 * 33] * g0[0], s[1 * 33] * g0[1]); o.y = pk2(s[2 * 33] * g0[2], s[3 * 33] * g0[3]); o.z = pk2(s[4 * 33] * g1[0], s[5 * 33] * g1[1]); o.w = pk2(s[6 * 33] * g1[2], s[7 * 33] * g1[3]);
        *(u32x4*)(WT + (size_t)(n0 + n) * K + k0 + 8 * c) = o; }
    asm volatile("s_waitcnt lgkmcnt(0)" ::: "memory");
}

constexpr int I_GU = 16 * 176, I_DN = 44 * 32, I_IN = 16 * 112, I_OUT = 16 * 32, I_LAYER = 2 * I_GU + 2 * I_DN + I_IN + I_OUT;
__device__ __forceinline__ void conv_item(const Ctx& C, const int l, int r, LAS float* scr, const int lane) {
    unsigned char* wl = C.ws + WS_W + (size_t)l * W_LAYER;
    int kind, ff = 0;
    if (r < I_GU) { kind = 0; ff = 0; } else if ((r -= I_GU) < I_DN) { kind = 1; ff = 0; } else if ((r -= I_DN) < I_IN) { kind = 2; } else if ((r -= I_IN) < I_OUT) { kind = 3; }
    else if ((r -= I_OUT) < I_GU) { kind = 0; ff = 1; } else { r -= I_GU; kind = 1; ff = 1; }
    if (kind == 0) {
        const int kb = r / 176, nb = r % 176, n0 = 32 * nb, tile = n0 >> 8, within = n0 & 255;
        const float* src = (within < 128) ? (ff ? C.ffn2_w_gate() : C.ffn1_w_gate()) : (ff ? C.ffn2_w_up() : C.ffn1_w_up());
        tr_item(src + (size_t)l * DM * FF, FF, 128 * tile + (within & 127), (ff ? C.norm_ffn2() : C.norm_ffn1()) + l * DM, (bf16_t*)(wl + (ff ? WO_GU2 : WO_GU1)), DM, n0, 64 * kb, scr, lane);
    } else if (kind == 1) {
        const int kb = r / 32, nb = r % 32;
        tr_item((ff ? C.ffn2_w_down() : C.ffn1_w_down()) + (size_t)l * FF * DM, DM, 32 * nb, nullptr, (bf16_t*)(wl + (ff ? WO_DN2 : WO_DN1)), FF, 32 * nb, 64 * kb, scr, lane);
    } else if (kind == 2) {
        const int kb = r / 112, nb = r % 112, n0 = 32 * nb;
        tr_item(C.w_in() + (size_t)l * DM * PROJ, PROJ, n0 < 2048 ? n0 : n0 + 8, C.norm_mix() + l * DM, (bf16_t*)(wl + WO_IN), DM, n0, 64 * kb, scr, lane);
    } else {
        const int kb = r / 32, nb = r % 32;
        tr_item(C.w_out() + (size_t)l * DM * DM, DM, 32 * nb, nullptr, (bf16_t*)(wl + WO_OUT), DM, 32 * nb, 64 * kb, scr, lane);
    }
}
constexpr int GU_UNITS = (MT / 256) * (NGU / 256), I_PRO = I_GU + I_DN, I_LATE0 = I_LAYER - I_DN;
__device__ __forceinline__ bool conv_deferred(const Ctx& C) { return C.G == 256; }
__device__ __forceinline__ void conv_slot_a(const Ctx& C, const int tid0, LAS unsigned char* lds) {
    const int lane = tid0 & 63, wave = tid0 >> 6;
    const int nfull = GU_UNITS % C.G, nidle = C.G - nfull, vi = C.wg - nfull;
    if (vi < 0) return;
    LAS float* scr = (LAS float*)(lds + wave * 16384);
    for (int it = I_PRO + vi * 8 + wave; it < I_LATE0; it += nidle * 8) conv_item(C, 0, it, scr, lane);
}
__device__ __forceinline__ void conv_slot(const Ctx& C, const int tid0, const int vi, const int nidle, const int first, const int last, LAS unsigned char* lds) {
    const int lane = tid0 & 63, wave = tid0 >> 6;
    LAS float* scr = (LAS float*)(lds + wave * 16384);
    if (vi >= 0) for (int it = first + vi * 8 + wave; it < last; it += nidle * 8) conv_item(C, it / I_LAYER, it % I_LAYER, scr, lane);
}
__device__ __forceinline__ void conv_slot_b(const Ctx& C, const int tid0, const int vi, const int nidle, LAS unsigned char* lds) {
    const int lane = tid0 & 63, wave = tid0 >> 6;
    LAS float* scr = (LAS float*)(lds + wave * 16384);
    for (int it = I_LATE0 + vi * 8 + wave; it < 2 * I_LAYER; it += nidle * 8) conv_item(C, it / I_LAYER, it % I_LAYER, scr, lane);
}
__device__ __forceinline__ void p0_prologue(const Ctx& C, const int tid0, LAS unsigned char* lds) {
    const int tid = tid0, lane = tid & 63, wave = tid >> 6;
    LAS float* scr = (LAS float*)(lds + wave * 16384);
    const int gw = C.wg * 8 + wave, NGW = C.G * 8;
    const int nconv = conv_deferred(C) ? I_PRO : 2 * I_LAYER;
    for (int it = gw; it < nconv; it += NGW) conv_item(C, it / I_LAYER, it % I_LAYER, scr, lane);
    for (int i = C.wg * 512 + tid; i < 2 * 16 * DM; i += C.G * 512) {
        const int l = i >> 14, j = (i >> 10) & 15, k = i & 1023;
        const float wv = (j < 8) ? C.w_in()[((size_t)l * DM + k) * PROJ + 2048 + j] * C.norm_mix()[l * DM + k] : 0.f;
        const unsigned hi = f2bf(wv), lo = f2bf(wv - bf2f(hi));
        bf16_t* t = (bf16_t*)C.wba() + (size_t)l * 2 * 16 * DM;
        t[j * DM + k] = (bf16_t)hi; t[16 * DM + j * DM + k] = (bf16_t)lo;
    }
    for (int i = C.wg * 512 + tid; i < 32 * 16 * 64; i += C.G * 512) if (((i >> 6) & 15) >= 8) C.km()[i] = 0;
    constexpr int U = 3;
    for (int m0 = gw; m0 < MT; m0 += U * NGW) {
        f32x4 v[U][4];
#pragma unroll
        for (int k = 0; k < U; ++k) { const int m = m0 + k * NGW;
            const float* src = (m < MP) ? C.x_prompt() + (size_t)m * DM : C.x_sample() + (size_t)(m - MP) * DM;
#pragma unroll
            for (int j = 0; j < 4; ++j) { v[k][j] = (f32x4){0.f, 0.f, 0.f, 0.f}; if (m < MT) v[k][j] = *(const f32x4*)(src + 4 * lane + 256 * j); } }
#pragma unroll
        for (int k = 0; k < U; ++k) { const int m = m0 + k * NGW;
            if (m < MT) {
                float ss = 0.f;
#pragma unroll
                for (int j = 0; j < 4; ++j) {
                    u32x2 w; w.x = pk2(v[k][j][0], v[k][j][1]); w.y = pk2(v[k][j][2], v[k][j][3]);
                    *(u32x2*)(C.xb() + (size_t)m * DM + 4 * lane + 256 * j) = w;
                    ss += (v[k][j][0] * v[k][j][0] + v[k][j][1] * v[k][j][1]) + (v[k][j][2] * v[k][j][2] + v[k][j][3] * v[k][j][3]);
                }
                ss = wave_sum(ss);
                if (lane < 16) C.ssq()[(size_t)m * 16 + lane] = (lane == 0) ? ss : 0.f;
            }
        }
    }
}

__device__ __forceinline__ void ba_rows(const Ctx& C, const int tid0, int l) {
    const int tid = tid0, lane = tid & 63, wave = tid >> 6, g4 = lane >> 4, l15 = lane & 15;
    const bf16_t* wh = (const bf16_t*)C.wba() + (size_t)l * 2 * 16 * DM + (size_t)l15 * DM + 8 * g4;
    const bf16_t* wl = wh + 16 * DM;
    const int nfull = ((MT / 256) * (NIN / 256)) % C.G, nidle = (nfull == 0) ? C.G : C.G - nfull, vi = (nfull == 0) ? C.wg : C.wg - nfull;
    if (vi >= 0) for (int rt = vi * 8 + wave; rt < MT / 16; rt += nidle * 8) {
        const bf16_t* xp = C.xb() + (size_t)(16 * rt + l15) * DM + 8 * g4;
        f32x4 acc = {0.f, 0.f, 0.f, 0.f};
#pragma unroll 8
        for (int ks = 0; ks < 32; ++ks) {
            const bf16x8 ah = *(const bf16x8*)(xp + 32 * ks);
            const bf16x8 bh = *(const bf16x8*)(wh + 32 * ks), bl = *(const bf16x8*)(wl + 32 * ks);
            acc = MFMA16(ah, bh, acc);
            acc = MFMA16(ah, bl, acc);
        }
        if (l15 < 8) {
            const int h = l15 & 3;
            const float bias = C.gdn_dt_bias()[l * 4 + h], ea = __expf(C.gdn_a_log()[l * 4 + h]);
#pragma unroll
            for (int r = 0; r < 4; ++r) {
                const int row = 16 * rt + 4 * g4 + r;
                const float res = acc[r] * pg8::row_rstd(C.ssq(), row);
                float o;
                if (l15 < 4) o = __builtin_amdgcn_rcpf(1.0f + __expf(-res));
                else { const float xx = res + bias, tt = __expf(xx); const float sp = (xx > 20.f) ? xx : ((xx < -4.f) ? tt * (1.0f - 0.5f * tt) : __logf(1.0f + tt)); o = -ea * sp; }
                C.ba()[(size_t)row * 8 + l15] = o;
            }
        }
    }
}

constexpr int G1_KN = 0, G1_QN = 18432, G1_KB = 36864, G1_VB = 55296, G1_KT = 73728, G1_LM = 92160, G1_TM = 109568, G1_LB = 118784, G1_SC = 128000, G1_WU = 0;
constexpr int G1_ST = 288, G1_WUST = 544, G1_TMST = 144;
#ifndef G1REPS
#define G1REPS 1,1,1,1,1
#endif
constexpr int G1R[5] = {G1REPS};

struct G1Regs { unsigned rowq[11], rowk[11], rowv[11]; float bet, gg; };
__device__ __forceinline__ void g1_load(const Ctx& C, const int tid0, int item, G1Regs& R) {
    const int lane = tid0 & 63, w = tid0 >> 6;
    const int b = item >> 7, h = (item >> 5) & 3, c = item & 31;
    const int grow0 = b * SEQ + 64 * c;
    const int dcol = h * 128 + 2 * lane;
#pragma unroll
    for (int j = 0; j < 11; ++j) {
        const int p = 8 * w - 3 + j;
        R.rowq[j] = 0u; R.rowk[j] = 0u; R.rowv[j] = 0u;
        if (c > 0 || p >= 0) { const bf16_t* rp = C.gqkv() + (size_t)(grow0 + p) * 1536 + dcol; R.rowq[j] = *(const unsigned*)rp; R.rowk[j] = *(const unsigned*)(rp + 512); R.rowv[j] = *(const unsigned*)(rp + 1024); }
    }
    const float* ba = C.ba() + (size_t)(grow0 + lane) * 8;
    R.bet = ba[h]; R.gg = ba[4 + h];
}
__device__ __forceinline__ void g1_chunk(const Ctx& C, const int tid0, int l, int item, int next_item, G1Regs& R, LAS unsigned char* lds) {
    const int tid = tid0, lane = tid & 63, w = tid >> 6, g4 = lane >> 4, l15 = lane & 15;
    const int b = item >> 7, h = (item >> 5) & 3, c = item & 31;
    const int grow0 = b * SEQ + 64 * c;
    LAS float* scal = (LAS float*)(lds + G1_SC);
    LAS float* LM = (LAS float*)(lds + G1_LM);
    float a_gc, a_bet, a_eg, a_ek;
    {
        float x = R.gg;
#pragma unroll
        for (int d = 1; d < 64; d <<= 1) { const float t = __shfl_up(x, d); if (lane >= d) x += t; }
        const float gl = __shfl(x, 63);
        a_gc = x; a_bet = R.bet; a_eg = __expf(x); a_ek = __expf(gl - x);
        if (w == 0) { scal[lane] = a_gc; scal[64 + lane] = a_bet; scal[128 + lane] = a_eg; scal[192 + lane] = a_ek; if (lane == 0) C.gcd()[item] = __expf(gl); }
    }
    unsigned rowq[11], rowk[11], rowv[11];
#pragma unroll
    for (int j = 0; j < 11; ++j) { rowq[j] = R.rowq[j]; rowk[j] = R.rowk[j]; rowv[j] = R.rowv[j]; }
    const int dcol = h * 128 + 2 * lane;
    for (int g1r = 0; g1r < G1R[0]; ++g1r) {
        const float* cw = C.gdn_conv_w() + (size_t)l * 4 * 1536;
        float wq[4][2], wk[4][2], wv[4][2];
#pragma unroll
        for (int tp = 0; tp < 4; ++tp) { wq[tp][0] = cw[tp * 1536 + dcol]; wq[tp][1] = cw[tp * 1536 + dcol + 1]; wk[tp][0] = cw[tp * 1536 + 512 + dcol]; wk[tp][1] = cw[tp * 1536 + 512 + dcol + 1];
            wv[tp][0] = cw[tp * 1536 + 1024 + dcol]; wv[tp][1] = cw[tp * 1536 + 1024 + dcol + 1]; }
        float rq[3][2], rk[3][2], rv[3][2];
#pragma unroll
        for (int j = 0; j < 3; ++j) {
            const unsigned uq = rowq[j], uk = rowk[j], uv = rowv[j];
            rq[j][0] = bf2f(uq & 0xffffu); rq[j][1] = bf2f(uq >> 16); rk[j][0] = bf2f(uk & 0xffffu); rk[j][1] = bf2f(uk >> 16); rv[j][0] = bf2f(uv & 0xffffu); rv[j][1] = bf2f(uv >> 16);
        }
#pragma unroll
        for (int i = 0; i < 8; ++i) {
            const int p = 8 * w + i;
            const unsigned uq = rowq[3 + i], uk = rowk[3 + i], uv = rowv[3 + i];
            float cq[2] = {bf2f(uq & 0xffffu), bf2f(uq >> 16)}, ck[2] = {bf2f(uk & 0xffffu), bf2f(uk >> 16)}, cv[2] = {bf2f(uv & 0xffffu), bf2f(uv >> 16)};
            float yq[2], yk[2], yv[2];
#pragma unroll
            for (int e = 0; e < 2; ++e) {
                yq[e] = silu_f(wq[0][e] * rq[0][e] + wq[1][e] * rq[1][e] + wq[2][e] * rq[2][e] + wq[3][e] * cq[e]);
                yk[e] = silu_f(wk[0][e] * rk[0][e] + wk[1][e] * rk[1][e] + wk[2][e] * rk[2][e] + wk[3][e] * ck[e]);
                yv[e] = silu_f(wv[0][e] * rv[0][e] + wv[1][e] * rv[1][e] + wv[2][e] * rv[2][e] + wv[3][e] * cv[e]);
                rq[0][e] = rq[1][e]; rq[1][e] = rq[2][e]; rq[2][e] = cq[e];
                rk[0][e] = rk[1][e]; rk[1][e] = rk[2][e]; rk[2][e] = ck[e];
                rv[0][e] = rv[1][e]; rv[1][e] = rv[2][e]; rv[2][e] = cv[e];
            }
            const float sq = wave_sum(yq[0] * yq[0] + yq[1] * yq[1]), sk = wave_sum(yk[0] * yk[0] + yk[1] * yk[1]);
            const float nq = __builtin_amdgcn_rsqf(sq + EPS) * 0.08838834764831845f, nk = __builtin_amdgcn_rsqf(sk + EPS);
            const float bet = __builtin_bit_cast(float, __builtin_amdgcn_readlane(__builtin_bit_cast(int, a_bet), p)), eg = __builtin_bit_cast(float, __builtin_amdgcn_readlane(__builtin_bit_cast(int, a_eg), p)), ek = __builtin_bit_cast(float, __builtin_amdgcn_readlane(__builtin_bit_cast(int, a_ek), p));
            const float q0 = yq[0] * nq, q1 = yq[1] * nq, k0 = yk[0] * nk, k1 = yk[1] * nk;
            const int o = p * G1_ST + 4 * lane;
            *(LAS unsigned*)(lds + G1_KN + o) = pk2(k0, k1);
            *(LAS unsigned*)(lds + G1_QN + o) = pk2(q0, q1);
            *(LAS unsigned*)(lds + G1_KB + o) = pk2(k0 * (bet * eg), k1 * (bet * eg));
            *(LAS unsigned*)(lds + G1_VB + o) = pk2(yv[0] * bet, yv[1] * bet);
            *(LAS unsigned*)(lds + G1_KT + o) = pk2(k0 * ek, k1 * ek);
            *(unsigned*)(C.gqd() + ((size_t)item * 64 + p) * 128 + 2 * lane) = pk2(q0 * eg, q1 * eg);
        }
    }
    LDS_BARRIER();
    for (int g1r = 0; g1r < G1R[1]; ++g1r) {
    int lane_c = lane; asm volatile("" : "+v"(lane_c));
    if (w < 4) {
        const int lane = lane_c, g4 = lane >> 4, l15 = lane & 15;
        const int it = w;
        bf16x8 af[4];
#pragma unroll
        for (int ks = 0; ks < 4; ++ks) af[ks] = *(const LAS bf16x8*)(lds + G1_KN + (16 * it + l15) * G1_ST + (32 * ks + 8 * g4) * 2);
        for (int jt = 0; jt <= it; ++jt) {
            f32x4 acc = {0.f, 0.f, 0.f, 0.f};
#pragma unroll
            for (int ks = 0; ks < 4; ++ks) { const bf16x8 bfr = *(const LAS bf16x8*)(lds + G1_KN + (16 * jt + l15) * G1_ST + (32 * ks + 8 * g4) * 2); acc = MFMA16(af[ks], bfr, acc); }
            const int j = 16 * jt + l15; const float gj = scal[j];
#pragma unroll
            for (int r = 0; r < 4; ++r) { const int i = 16 * it + 4 * g4 + r; const float lv = (i > j) ? scal[64 + i] * acc[r] * __expf(scal[i] - gj) : 0.f; LM[i * 68 + j] = lv; *(LAS bf16_t*)(lds + G1_LB + i * G1_TMST + j * 2) = (bf16_t)f2bf(lv); }
        }
    } else {
        const int lane = lane_c, g4 = lane >> 4, l15 = lane & 15;
        const int it = w - 4;
        bf16x8 bq[4];
#pragma unroll
        for (int ks = 0; ks < 4; ++ks) bq[ks] = *(const LAS bf16x8*)(lds + G1_QN + (16 * it + l15) * G1_ST + (32 * ks + 8 * g4) * 2);
        const int i = 16 * it + l15; const float gi = scal[i];
#pragma unroll
        for (int jt = 0; jt < 4; ++jt) {
            f32x4 acc = {0.f, 0.f, 0.f, 0.f};
#pragma unroll
            for (int ks = 0; ks < 4; ++ks) { const bf16x8 ak = *(const LAS bf16x8*)(lds + G1_KN + (16 * jt + l15) * G1_ST + (32 * ks + 8 * g4) * 2); acc = MFMA16(ak, bq[ks], acc); }
            float v[4];
#pragma unroll
            for (int r = 0; r < 4; ++r) { const int j = 16 * jt + 4 * g4 + r; v[r] = (i >= j) ? acc[r] * __expf(gi - scal[j]) : 0.f; }
            u32x2 o; o.x = pk2(v[0], v[1]); o.y = pk2(v[2], v[3]);
            *(u32x2*)(C.gatt() + ((size_t)item * 64 + i) * 64 + 16 * jt + 4 * g4) = o;
        }
    }
    }
    LDS_BARRIER();
    if (w == 0) for (int g1r = 0; g1r < G1R[2]; ++g1r) {
        int lane_d = lane; asm volatile("" : "+v"(lane_d));
        const int d = lane_d >> 4, cc = lane_d & 15;
        const LAS float* Ld = LM + (16 * d) * 68 + 16 * d;
        float t[16];
#pragma unroll
        for (int i = 0; i < 16; ++i) {
            float s0 = 0.f, s1 = 0.f;
#pragma unroll
            for (int j4 = 0; j4 < i; j4 += 4) {
                const f32x4 Lv = *(const LAS f32x4*)(Ld + i * 68 + j4);
                if (j4 + 0 < i) s0 += Lv[0] * t[j4 + 0];
                if (j4 + 1 < i) s1 += Lv[1] * t[j4 + 1];
                if (j4 + 2 < i) s0 += Lv[2] * t[j4 + 2];
                if (j4 + 3 < i) s1 += Lv[3] * t[j4 + 3];
            }
            t[i] = ((cc == i) ? 1.f : 0.f) - (s0 + s1);
        }
#pragma unroll
        for (int i = 0; i < 16; ++i) *(LAS bf16_t*)(lds + G1_TM + (16 * d + i) * G1_TMST + (16 * d + cc) * 2) = (bf16_t)f2bf(t[i]);
    }
    LDS_BARRIER();
    for (int g1r = 0; g1r < G1R[3]; ++g1r) {
        int lane_e = lane; asm volatile("" : "+v"(lane_e));
        const int lane = lane_e, g4 = lane >> 4, l15 = lane & 15;
#pragma unroll
        for (int bi = 0; bi < 4; ++bi) {
            u32x2 tdiag = *(const LAS u32x2*)(lds + G1_TM + (16 * bi + l15) * G1_TMST + (16 * bi + 4 * g4) * 2);
            u32x4 ta4; ta4.x = tdiag.x; ta4.y = tdiag.y; ta4.z = 0u; ta4.w = 0u;
            const bf16x8 tA = __builtin_bit_cast(bf16x8, ta4);
#pragma unroll
            for (int cq = 0; cq < 2; ++cq) {
                const int ct = 2 * w + cq, feat = 16 * ct + l15;
                const LAS unsigned char* img = lds + (ct < 8 ? G1_KB : G1_VB);
                const int col = 16 * (ct & 7) + l15;
                f32x4 y;
#pragma unroll
                for (int e = 0; e < 4; ++e) y[e] = bf2f(*(const LAS bf16_t*)(img + (16 * bi + 4 * g4 + e) * G1_ST + col * 2));
                if (bi > 0) {
                    f32x4 pacc = {0.f, 0.f, 0.f, 0.f};
#pragma unroll
                    for (int s2 = 0; s2 < (bi + 1) / 2; ++s2) {
                        const bool valid = (32 * s2 + 8 * g4) < 16 * bi;
                        u32x4 la = *(const LAS u32x4*)(lds + G1_LB + (16 * bi + l15) * G1_TMST + (32 * s2 + 8 * g4) * 2);
                        u32x4 xb = __builtin_bit_cast(u32x4, tr_frag(lds + G1_WU, G1_WUST, 32 * s2 + 8 * g4, 32 * s2 + 8 * g4 + 4, 16 * ct, lane));
                        if (!valid) { la = (u32x4){0u, 0u, 0u, 0u}; xb = (u32x4){0u, 0u, 0u, 0u}; }
                        pacc = MFMA16(__builtin_bit_cast(bf16x8, la), __builtin_bit_cast(bf16x8, xb), pacc);
                    }
                    y = y - pacc;
                }
                u32x4 yb; yb.x = pk2(y[0], y[1]); yb.y = pk2(y[2], y[3]); yb.z = 0u; yb.w = 0u;
                const f32x4 x = MFMA16(tA, __builtin_bit_cast(bf16x8, yb), ((f32x4){0.f, 0.f, 0.f, 0.f}));
#pragma unroll
                for (int e = 0; e < 4; ++e) {
                    const int pos = 16 * bi + 4 * g4 + e; const float v = x[e];
                    *(LAS bf16_t*)(lds + G1_WU + pos * G1_WUST + feat * 2) = (bf16_t)f2bf(v);
                }
            }
            LDS_BARRIER();
        }
    }
    if (next_item >= 0) g1_load(C, tid0, next_item, R);
    {
        int tid_e = tid; asm volatile("" : "+v"(tid_e));
        const int pos = tid_e >> 3, ch = tid_e & 7;
        bf16_t* wrow = C.gw() + ((size_t)item * 64 + pos) * 128 + ch * 8;
        bf16_t* urow = (bf16_t*)C.gu() + ((size_t)item * 64 + pos) * 128 + ch * 8;
        const LAS unsigned char* src = lds + G1_WU + pos * G1_WUST + ch * 16;
        *(u32x4*)wrow = *(const LAS u32x4*)src; *(u32x4*)(wrow + 64) = *(const LAS u32x4*)(src + 128);
        *(u32x4*)urow = *(const LAS u32x4*)(src + 256); *(u32x4*)(urow + 64) = *(const LAS u32x4*)(src + 384);
    }
    for (int g1r = 0; g1r < G1R[4]; ++g1r) {
        int lane_f = lane; asm volatile("" : "+v"(lane_f));
        const int lane = lane_f, g4 = lane >> 4, l15 = lane & 15;
        bf16x8 wa[2], ka[2];
#pragma unroll
        for (int ks = 0; ks < 2; ++ks) { wa[ks] = tr_frag(lds + G1_WU, G1_WUST, 32 * ks + 8 * g4, 32 * ks + 8 * g4 + 4, 16 * w, lane);
                                         ka[ks] = tr_frag(lds + G1_KT, G1_ST, 32 * ks + 8 * g4, 32 * ks + 8 * g4 + 4, 16 * w, lane); }
#pragma unroll
        for (int at = 0; at < 8; ++at) {
            f32x4 acc = {0.f, 0.f, 0.f, 0.f};
#pragma unroll
            for (int ks = 0; ks < 2; ++ks) { const bf16x8 kb = tr_frag(lds + G1_KT, G1_ST, 32 * ks + 8 * g4, 32 * ks + 8 * g4 + 4, 16 * at, lane); acc = MFMA16(wa[ks], kb, acc); }
            u32x2 o; o.x = pk2(-acc[0], -acc[1]); o.y = pk2(-acc[2], -acc[3]);
            *(u32x2*)(C.gap() + ((size_t)item * 128 + 16 * at + l15) * 128 + 32 * (w >> 1) + 8 * g4 + 4 * (w & 1)) = o;
        }
#pragma unroll
        for (int et = 0; et < 8; ++et) {
            f32x4 acc = {0.f, 0.f, 0.f, 0.f};
#pragma unroll
            for (int ks = 0; ks < 2; ++ks) { const bf16x8 ub = tr_frag(lds + G1_WU, G1_WUST, 32 * ks + 8 * g4, 32 * ks + 8 * g4 + 4, 128 + 16 * et, lane); acc = MFMA16(ka[ks], ub, acc); }
            { u32x2 o; o.x = pk2(acc[0], acc[1]); o.y = pk2(acc[2], acc[3]); *(u32x2*)((bf16_t*)C.gbc() + ((((size_t)item * 8 + et) * 8 + w) * 64 + lane) * 4) = o; }
        }
    }
    LDS_BARRIER();
}

__device__ __forceinline__ void g2_scan(const Ctx& C, const int tid0, int l, int unit, LAS unsigned char* lds) {
    const int tid = tid0, lane = tid & 63, w = tid >> 6, g4 = lane >> 4, l15 = lane & 15;
    const int bh = unit >> 2, sl2 = unit & 3, b = bh >> 2, h = bh & 3;
    f32x4 D[2];
    D[0] = (f32x4){0.f, 0.f, 0.f, 0.f}; D[1] = (f32x4){0.f, 0.f, 0.f, 0.f};
    for (int i = tid; i < 2 * 9216 / 4; i += 512) ((LAS unsigned*)lds)[i] = 0u;
    const bf16_t* ap0 = C.gap() + ((size_t)(bh * 32) * 128 + 16 * w + l15) * 128 + 8 * g4;
    const bf16_t* bc0 = (const bf16_t*)C.gbc() + ((((size_t)(bh * 32) * 8 + 2 * sl2) * 8 + w) * 64 + lane) * 4;
    bf16x8 a0[4], a1[4], a2[4], a3[4]; u32x2 c0[2], c1[2], c2[2], c3[2]; float d0, d1, d2, d3;
#define G2_LOAD(AR, CR, DR, CC) do { _Pragma("unroll") for (int s = 0; s < 4; ++s) AR[s] = *(const bf16x8*)(ap0 + (size_t)(CC) * 16384 + 32 * s); \
        CR[0] = *(const u32x2*)(bc0 + (size_t)(CC) * 16384); CR[1] = *(const u32x2*)(bc0 + (size_t)(CC) * 16384 + 2048); DR = C.gcd()[bh * 32 + (CC)]; } while (0)
#define G2_STEP(AR, CR, DR, CC) do { const int c = (CC); const int item = bh * 32 + c; f32x4 bc[2]; \
        _Pragma("unroll") for (int j = 0; j < 2; ++j) bc[j] = (f32x4){bf2f(CR[j].x & 0xffffu), bf2f(CR[j].x >> 16), bf2f(CR[j].y & 0xffffu), bf2f(CR[j].y >> 16)}; \
        const float cd = DR; bf16x8 a[4]; _Pragma("unroll") for (int s = 0; s < 4; ++s) a[s] = AR[s]; \
        if (c + 4 < 32) G2_LOAD(AR, CR, DR, c + 4); \
        u32x4 bfr[2][4];                                        \
        _Pragma("unroll") for (int j = 0; j < 2; ++j) { const LAS unsigned char* rb = lds + (c & 1) * 9216 + (16 * j + l15) * 288; \
            _Pragma("unroll") for (int s = 0; s < 4; ++s) { const u32x2 lo = *(const LAS u32x2*)(rb + (32 * s + 4 * g4) * 2), hi = *(const LAS u32x2*)(rb + (32 * s + 16 + 4 * g4) * 2); \
                bfr[j][s].x = lo.x; bfr[j][s].y = lo.y; bfr[j][s].z = hi.x; bfr[j][s].w = hi.y; } } \
        _Pragma("unroll") for (int j = 0; j < 2; ++j) { \
            { u32x2 o; o.x = pk2(D[j][0], D[j][1]); o.y = pk2(D[j][2], D[j][3]); *(u32x2*)(C.gst() + ((size_t)item * 128 + 32 * sl2 + 16 * j + l15) * 128 + 16 * w + 4 * g4) = o; } \
            D[j] = D[j] * cd + bc[j]; } \
        asm volatile("s_waitcnt lgkmcnt(0)" ::: "memory"); \
        _Pragma("unroll") for (int s = 0; s < 4; ++s) \
            _Pragma("unroll") for (int j = 0; j < 2; ++j) D[j] = MFMA16(a[s], __builtin_bit_cast(bf16x8, bfr[j][s]), D[j]);     \
        _Pragma("unroll") for (int j = 0; j < 2; ++j) \
            { u32x2 o; o.x = pk2(D[j][0], D[j][1]); o.y = pk2(D[j][2], D[j][3]); *(LAS u32x2*)(lds + ((c + 1) & 1) * 9216 + (16 * j + l15) * 288 + (16 * w + 4 * g4) * 2) = o; } \
        LDS_BARRIER(); } while (0)
    G2_LOAD(a0, c0, d0, 0); G2_LOAD(a1, c1, d1, 1); G2_LOAD(a2, c2, d2, 2); G2_LOAD(a3, c3, d3, 3);
    LDS_BARRIER();
    for (int c4 = 0; c4 < 32; c4 += 4) { G2_STEP(a0, c0, d0, c4); G2_STEP(a1, c1, d1, c4 + 1); G2_STEP(a2, c2, d2, c4 + 2); G2_STEP(a3, c3, d3, c4 + 3); }
#undef G2_LOAD
#undef G2_STEP
    float* so = C.out + O_PGDN + ((size_t)(l * 8 + b) * 4 + h) * 16384;
#pragma unroll
    for (int j = 0; j < 2; ++j)
#pragma unroll
        for (int r = 0; r < 4; ++r) so[(16 * w + 4 * g4 + r) * 128 + 32 * sl2 + 16 * j + l15] = D[j][r];
}

__device__ __forceinline__ void g3_pair(const Ctx& C, const int tid0, int l, int pairidx, LAS unsigned char* lds) {
    const int tid = tid0, lane = tid & 63, w = tid >> 6, g4 = lane >> 4, l15 = lane & 15;
    const int half = w >> 2, pt = w & 3, item = 2 * pairidx + half;
    const int b = item >> 7, h = (item >> 5) & 3, c = item & 31;
    LAS unsigned char* ST = lds + half * 53248;
    LAS unsigned char* UT = ST + 34816;
    {
        const int tl = tid & 255;
        const bf16_t* sp = C.gst() + (size_t)item * 16384;
#pragma unroll
        for (int i = 0; i < 8; ++i) { const int q = tl + 256 * i; *(LAS u32x4*)(ST + (q >> 4) * 272 + (q & 15) * 16) = *(const u32x4*)(sp + (q >> 4) * 128 + (q & 15) * 8); }
    }
    const int pos = 16 * pt + l15;
    const size_t row = (size_t)b * SEQ + 64 * c + pos;
    bf16x8 wf[4], qf[4], af[2]; f32x4 u4[8]; u32x2 zz[8];
#pragma unroll
    for (int ks = 0; ks < 4; ++ks) { wf[ks] = *(const bf16x8*)(C.gw() + ((size_t)item * 64 + pos) * 128 + 32 * ks + 8 * g4); qf[ks] = *(const bf16x8*)(C.gqd() + ((size_t)item * 64 + pos) * 128 + 32 * ks + 8 * g4); }
#pragma unroll
    for (int ks = 0; ks < 2; ++ks) af[ks] = *(const bf16x8*)(C.gatt() + ((size_t)item * 64 + pos) * 64 + 32 * ks + 8 * g4);
#pragma unroll
    for (int dt = 0; dt < 8; ++dt) { const u32x2 ub = *(const u32x2*)((const bf16_t*)C.gu() + ((size_t)item * 64 + pos) * 128 + 16 * dt + 4 * g4); u4[dt] = (f32x4){bf2f(ub.x & 0xffffu), bf2f(ub.x >> 16), bf2f(ub.y & 0xffffu), bf2f(ub.y >> 16)}; zz[dt] = *(const u32x2*)(C.gz() + row * 512 + h * 128 + 16 * dt + 4 * g4); }
    f32x4 nwv[8];
#pragma unroll
    for (int dt = 0; dt < 8; ++dt) nwv[dt] = *(const f32x4*)(C.gdn_norm_w() + l * 128 + 16 * dt + 4 * g4);
    LDS_BARRIER();
    f32x4 accW[8], accO[8];
#pragma unroll
    for (int dt = 0; dt < 8; ++dt) { accW[dt] = (f32x4){0.f, 0.f, 0.f, 0.f}; accO[dt] = (f32x4){0.f, 0.f, 0.f, 0.f};
#pragma unroll
        for (int ks = 0; ks < 4; ++ks) { const bf16x8 a = *(const LAS bf16x8*)(ST + (16 * dt + l15) * 272 + (32 * ks + 8 * g4) * 2); accW[dt] = MFMA16(a, wf[ks], accW[dt]); accO[dt] = MFMA16(a, qf[ks], accO[dt]); } }
#pragma unroll
    for (int dt = 0; dt < 8; ++dt) {
#pragma unroll
        for (int r = 0; r < 4; ++r) *(LAS bf16_t*)(UT + (16 * dt + 4 * g4 + r) * 144 + pos * 2) = (bf16_t)f2bf(u4[dt][r] - accW[dt][r]);
    }
    LDS_BARRIER();
#pragma unroll
    for (int dt = 0; dt < 8; ++dt)
#pragma unroll
        for (int ks = 0; ks < 2; ++ks) { const bf16x8 a = *(const LAS bf16x8*)(UT + (16 * dt + l15) * 144 + (32 * ks + 8 * g4) * 2); accO[dt] = MFMA16(a, af[ks], accO[dt]); }
    float ss = 0.f;
#pragma unroll
    for (int dt = 0; dt < 8; ++dt) ss += (accO[dt][0] * accO[dt][0] + accO[dt][1] * accO[dt][1]) + (accO[dt][2] * accO[dt][2] + accO[dt][3] * accO[dt][3]);
    ss += __shfl_xor(ss, 16); ss += __shfl_xor(ss, 32);
    const float rstd = __builtin_amdgcn_rsqf(ss * (1.0f / 128.0f) + EPS);
#pragma unroll
    for (int dt = 0; dt < 8; ++dt) {
        const int dv0 = 16 * dt + 4 * g4;
        const f32x4 nw = nwv[dt];
        const float z0 = bf2f(zz[dt].x & 0xffffu), z1 = bf2f(zz[dt].x >> 16), z2 = bf2f(zz[dt].y & 0xffffu), z3 = bf2f(zz[dt].y >> 16);
        u32x2 o; o.x = pk2(accO[dt][0] * rstd * nw[0] * silu_f(z0), accO[dt][1] * rstd * nw[1] * silu_f(z1)); o.y = pk2(accO[dt][2] * rstd * nw[2] * silu_f(z2), accO[dt][3] * rstd * nw[3] * silu_f(z3));
        *(u32x2*)(C.mix() + row * DM + h * 128 + dv0) = o;
    }
    LDS_BARRIER();
}

__device__ __forceinline__ void km_item(const Ctx& C, const int tid0, int item, LAS unsigned char* lds) {
    const int tid = tid0, d = tid & 63, part = tid >> 6;
    const int bh = item >> 3, j = item & 7;
    const bf16_t* kp = C.mk() + ((size_t)bh * SEQ + 256 * j + 32 * part) * 64 + d;
    float s = 0.f;
#pragma unroll 8
    for (int i = 0; i < 32; ++i) s += bf2f(kp[i * 64]);
    LAS float* red = (LAS float*)lds;
    red[part * 64 + d] = s;
    LDS_BARRIER();
    if (tid < 64) { float t = 0.f;
#pragma unroll
        for (int q = 0; q < 8; ++q) t += red[q * 64 + tid];
        C.km()[((size_t)bh * 16 + j) * 64 + tid] = (bf16_t)f2bf(t * (1.0f / 256.0f)); }
    LDS_BARRIER();
}

constexpr int MO_K = 0, MO_V = 9216, MO_BUF = 18432, MO_ANY = 36864, MO_LIST = 36880, MO_ST = 144;
__device__ __forceinline__ void moba_tile(const LAS unsigned char* kimg, const LAS unsigned char* vimg, const int kt, const bool own, const bool rowsel, const int qg, const bf16x8 (&qf)[2],
                                          float& mrun, float& lrun, f32x4 (&oacc)[4], const int lane, const int g4, const int l15) {
    f32x4 st[4];
#pragma unroll
    for (int s = 0; s < 4; ++s) { st[s] = (f32x4){0.f, 0.f, 0.f, 0.f};
#pragma unroll
        for (int ks = 0; ks < 2; ++ks) { const bf16x8 a = *(const LAS bf16x8*)(kimg + (16 * s + l15) * MO_ST + (32 * ks + 8 * g4) * 2); st[s] = MFMA16(a, qf[ks], st[s]); } }
    const float rbias = rowsel ? 0.f : -30000.f;
    const bool diag = own && (64 * kt + 63 > qg - (lane & 15));
    float tmax = -30000.f;
    if (diag) {
#pragma unroll
        for (int s = 0; s < 4; ++s)
#pragma unroll
            for (int r = 0; r < 4; ++r) { const int key = 64 * kt + 16 * s + 4 * g4 + r; st[s][r] = (key <= qg) ? st[s][r] : -30000.f; tmax = fmaxf(tmax, st[s][r]); }
    } else {
#pragma unroll
        for (int s = 0; s < 4; ++s)
#pragma unroll
            for (int r = 0; r < 4; ++r) { st[s][r] += rbias; tmax = fmaxf(tmax, st[s][r]); }
    }
    tmax = fmaxf(tmax, __shfl_xor(tmax, 16)); tmax = fmaxf(tmax, __shfl_xor(tmax, 32));
    const float mnew = fmaxf(mrun, tmax);
    const float alpha = __builtin_amdgcn_exp2f((mrun - mnew) * 1.44269504f);
    mrun = mnew;
    const float mneg = -mnew * 1.44269504f;
    float psum = 0.f;
#pragma unroll
    for (int s = 0; s < 4; ++s)
#pragma unroll
        for (int r = 0; r < 4; ++r) { const float pv = __builtin_amdgcn_exp2f(fmaf(st[s][r], 1.44269504f, mneg)); st[s][r] = pv; psum += pv; }
    lrun = lrun * alpha + psum;
    bf16x8 pf[2];
#pragma unroll
    for (int ks = 0; ks < 2; ++ks) { u32x4 o; o.x = pk2(st[2 * ks][0], st[2 * ks][1]); o.y = pk2(st[2 * ks][2], st[2 * ks][3]); o.z = pk2(st[2 * ks + 1][0], st[2 * ks + 1][1]); o.w = pk2(st[2 * ks + 1][2], st[2 * ks + 1][3]);
        pf[ks] = __builtin_bit_cast(bf16x8, o); }
#pragma unroll
    for (int dt = 0; dt < 4; ++dt) {
        oacc[dt] = oacc[dt] * alpha;
#pragma unroll
        for (int ks = 0; ks < 2; ++ks) { const bf16x8 va = tr_frag(vimg, MO_ST, 32 * ks + 4 * g4, 32 * ks + 16 + 4 * g4, 16 * dt, lane); oacc[dt] = MFMA16(va, pf[ks], oacc[dt]); }
    }
}
__device__ __forceinline__ void moba_prompt_item(const Ctx& C, const int tid0, int bh, int qt, LAS unsigned char* lds) {
    const int tid = tid0, lane = tid & 63, w = tid >> 6, g4 = lane >> 4, l15 = lane & 15;
    const int bt = qt >> 1;
    const int q0 = 128 * qt + 16 * w, qg = q0 + l15;
    const bf16_t* qp = C.mq() + ((size_t)bh * SEQ + qg) * 64;
    bf16x8 qf[2];
#pragma unroll
    for (int ks = 0; ks < 2; ++ks) qf[ks] = *(const bf16x8*)(qp + 32 * ks + 8 * g4);
    LAS unsigned* anyw = (LAS unsigned*)(lds + MO_ANY);
    LAS int* tl = (LAS int*)(lds + MO_LIST);
    if (tid == 0) anyw[0] = 0u;
    unsigned sel = 0u;
    {
        f32x4 gacc = {0.f, 0.f, 0.f, 0.f};
#pragma unroll
        for (int ks = 0; ks < 2; ++ks) { const bf16x8 a = *(const bf16x8*)(C.km() + ((size_t)bh * 16 + l15) * 64 + 32 * ks + 8 * g4); gacc = MFMA16(a, qf[ks], gacc); }
        float gate[8];
#pragma unroll
        for (int r = 0; r < 4; ++r) { gate[r] = __shfl(gacc[r], l15); gate[4 + r] = __shfl(gacc[r], 16 + l15); }
#pragma unroll
        for (int j = 0; j < 8; ++j) {
            int rank = 0;
#pragma unroll
            for (int i = 0; i < 8; ++i) if (i != j) rank += (i < bt && (gate[i] > gate[j] || (gate[i] == gate[j] && i < j))) ? 1 : 0;
            if (j < bt && rank < 3) sel |= (1u << j);
        }
    }
    LDS_BARRIER();
    {
        unsigned m = sel;
#pragma unroll
        for (int o = 1; o < 64; o <<= 1) m |= (unsigned)__shfl_xor((int)m, o);
        if (lane == 0 && m) atomicOr((unsigned*)anyw, m);
    }
    LDS_BARRIER();
    const int last_tile = 2 * qt + 1;
    if (tid == 0) {
        const unsigned anysel = anyw[0]; int n = 0;
        for (int j = 0; j < bt; ++j) if ((anysel >> j) & 1u) for (int t = 0; t < 4; ++t) tl[n++] = 4 * j + t;
        for (int kt = 4 * bt; kt <= last_tile; ++kt) tl[n++] = kt;
        tl[63] = n;
    }
    LDS_BARRIER();
    const int nt = tl[63];
    float mrun = -30000.f, lrun = 0.f;
    f32x4 oacc[4];
#pragma unroll
    for (int dt = 0; dt < 4; ++dt) oacc[dt] = (f32x4){0.f, 0.f, 0.f, 0.f};
    const int ldr = tid >> 3, ldc = tid & 7;
    const bf16_t* kbase = C.mk() + ((size_t)bh * SEQ + ldr) * 64 + ldc * 8;
    const bf16_t* vbase = C.mv() + ((size_t)bh * SEQ + ldr) * 64 + ldc * 8;
    u32x4 k0, v0, k1, v1, k2, v2;
    k0 = *(const u32x4*)(kbase + (size_t)tl[0] * 4096); v0 = *(const u32x4*)(vbase + (size_t)tl[0] * 4096);
    k1 = k0; v1 = v0; k2 = k0; v2 = v0;
    if (1 < nt) { k1 = *(const u32x4*)(kbase + (size_t)tl[1] * 4096); v1 = *(const u32x4*)(vbase + (size_t)tl[1] * 4096); }
    if (2 < nt) { k2 = *(const u32x4*)(kbase + (size_t)tl[2] * 4096); v2 = *(const u32x4*)(vbase + (size_t)tl[2] * 4096); }
#define MO_STEP(n_, KR, VR) do { const int n = (n_); if (n < nt) { const int kt = tl[n]; const int j = kt >> 2; const bool own = (j == bt); \
        LAS unsigned char* kb = lds + (n & 1) * MO_BUF + MO_K; LAS unsigned char* vb = lds + (n & 1) * MO_BUF + MO_V; \
        *(LAS u32x4*)(kb + ldr * MO_ST + ldc * 16) = KR; *(LAS u32x4*)(vb + ldr * MO_ST + ldc * 16) = VR; \
        if (n + 3 < nt) { const int kn = tl[n + 3]; KR = *(const u32x4*)(kbase + (size_t)kn * 4096); VR = *(const u32x4*)(vbase + (size_t)kn * 4096); } \
        LDS_BARRIER(); \
        moba_tile(kb, vb, kt, own, own || ((sel >> j) & 1u), qg, qf, mrun, lrun, oacc, lane, g4, l15); } } while (0)
    for (int n0 = 0; n0 < nt; n0 += 3) { MO_STEP(n0, k0, v0); MO_STEP(n0 + 1, k1, v1); MO_STEP(n0 + 2, k2, v2); }
#undef MO_STEP
    lrun += __shfl_xor(lrun, 16); lrun += __shfl_xor(lrun, 32);
    const float inv = 1.0f / lrun;
    const int b = bh >> 2, h = bh & 3;
    bf16_t* op = C.mix() + ((size_t)b * SEQ + qg) * DM + 768 + h * 64;
#pragma unroll
    for (int dt = 0; dt < 4; ++dt) { u32x2 o; o.x = pk2(oacc[dt][0] * inv, oacc[dt][1] * inv); o.y = pk2(oacc[dt][2] * inv, oacc[dt][3] * inv); *(u32x2*)(op + 16 * dt + 4 * g4) = o; }
    LDS_BARRIER();
}

__device__ __forceinline__ void shortconv_all(const Ctx& C, const int tid0, int l, const int vi, const int nshare) {
    const float* cw = C.sc_conv_w() + (size_t)l * 3 * 256;
    for (int idx = vi * 512 + tid0; idx < MT * 128; idx += nshare * 512) {
        const int row = idx >> 7, c2 = (idx & 127) * 2;
        const bool samp = row >= MP; const int sr = row - MP;
        const int b = samp ? (sr >> 2) : (row >> 11), t = samp ? (sr & 3) : (row & 2047);
        float ch[3][2];
#pragma unroll
        for (int i = 0; i < 3; ++i) {
            const int tt = t - 2 + i;
            if (tt >= 0) { const bf16_t* p = C.sc() + (size_t)(row - 2 + i) * 768 + c2; const unsigned hh = *(const unsigned*)p, cc = *(const unsigned*)(p + 256);
                ch[i][0] = bf2f(hh & 0xffffu) * bf2f(cc & 0xffffu); ch[i][1] = bf2f(hh >> 16) * bf2f(cc >> 16); }
            else if (samp) { const float* hp = C.state_sconv() + ((size_t)(l * 128 + b) * 2 + (tt + 2)) * 256 + c2; ch[i][0] = hp[0]; ch[i][1] = hp[1]; }
            else { ch[i][0] = 0.f; ch[i][1] = 0.f; }
        }
        const unsigned gg = *(const unsigned*)(C.sc() + (size_t)row * 768 + 512 + c2);
        const float y0 = cw[c2] * ch[0][0] + cw[256 + c2] * ch[1][0] + cw[512 + c2] * ch[2][0];
        const float y1 = cw[c2 + 1] * ch[0][1] + cw[256 + c2 + 1] * ch[1][1] + cw[512 + c2 + 1] * ch[2][1];
        *(unsigned*)(C.mix() + (size_t)row * DM + 512 + c2) = pk2(bf2f(gg & 0xffffu) * y0, bf2f(gg >> 16) * y1);
        const int j = samp ? (t - 2) : (t - 2046);
        if (j >= 0) { float* o = C.out + (samp ? (O_SSCONV + ((size_t)(l * 128 + b) * 2 + j) * 256) : (O_PSCONV + ((size_t)(l * 8 + b) * 2 + j) * 256)) + c2; o[0] = ch[2][0]; o[1] = ch[2][1]; }
    }
}

__device__ __forceinline__ void gdn_sample_pair(const Ctx& C, const int tid0, int l, int it, LAS unsigned char* lds) {
    const int tid = tid0, grp = tid >> 8, tl = tid & 255, e = tl & 127, half = tl >> 7, lane = tid & 63, wsub = (tl >> 6) & 1;
    const int item = it * 2 + grp, b = item >> 2, h = item & 3;
    LAS float* ks = (LAS float*)(lds + grp * 16384);
    LAS float* qs = ks + 512;
    LAS float* pd = qs + 512;
    LAS float* po = pd + 256;
    LAS float* red = po + 1024;
    const size_t row0 = (size_t)MP + 4 * b;
    float yq[4], yk[4], yv[4];
    {
        const float* cw = C.gdn_conv_w() + (size_t)l * 4 * 1536;
        const int col = h * 128 + e;
        float xq[7], xk[7], xv[7];
#pragma unroll
        for (int j = 0; j < 3; ++j) { const float* hp = C.state_gdn_conv() + ((size_t)(l * 128 + b) * 3 + j) * 1536 + col; xq[j] = hp[0]; xk[j] = hp[512]; xv[j] = hp[1024]; }
#pragma unroll
        for (int t = 0; t < 4; ++t) { const bf16_t* rp = C.gqkv() + (row0 + t) * 1536 + col; xq[3 + t] = bf2f(rp[0]); xk[3 + t] = bf2f(rp[512]); xv[3 + t] = bf2f(rp[1024]); }
#pragma unroll
        for (int t = 0; t < 4; ++t) {
            float aq = 0.f, ak = 0.f, av = 0.f;
#pragma unroll
            for (int i = 0; i < 4; ++i) { aq += cw[i * 1536 + col] * xq[t + i]; ak += cw[i * 1536 + 512 + col] * xk[t + i]; av += cw[i * 1536 + 1024 + col] * xv[t + i]; }
            yq[t] = silu_f(aq); yk[t] = silu_f(ak); yv[t] = silu_f(av);
        }
    }
#pragma unroll
    for (int t = 0; t < 4; ++t) { const float a = wave_sum(yq[t] * yq[t]), bb = wave_sum(yk[t] * yk[t]); if (lane == 0 && half == 0) { red[wsub * 12 + t] = a; red[wsub * 12 + 4 + t] = bb; } }
    LDS_BARRIER();
    if (half == 0) {
#pragma unroll
        for (int t = 0; t < 4; ++t) {
            const float sq = red[t] + red[12 + t], sk = red[4 + t] + red[16 + t];
            qs[t * 128 + e] = yq[t] * __builtin_amdgcn_rsqf(sq + EPS) * 0.08838834764831845f;
            ks[t * 128 + e] = yk[t] * __builtin_amdgcn_rsqf(sk + EPS);
        }
    }
    LDS_BARRIER();
    float S[64];
    const float* sp = C.state_gdn() + ((size_t)(l * 128 + b) * 4 + h) * 16384 + (size_t)(64 * half) * 128 + e;
#pragma unroll
    for (int d = 0; d < 64; ++d) S[d] = __builtin_nontemporal_load(sp + d * 128);
    float o[4];
#pragma unroll
    for (int t = 0; t < 4; ++t) {
        const float* bap = C.ba() + (row0 + t) * 8;
        const float bet = bap[h], a = __expf(bap[4 + h]);
        float dot = 0.f;
#pragma unroll
        for (int d4 = 0; d4 < 64; d4 += 4) { const f32x4 kv = *(const LAS f32x4*)(ks + t * 128 + 64 * half + d4); dot += (kv[0] * S[d4] + kv[1] * S[d4 + 1]) + (kv[2] * S[d4 + 2] + kv[3] * S[d4 + 3]); }
        pd[half * 128 + e] = dot;
        LDS_BARRIER();
        const float u = bet * (yv[t] - a * (pd[e] + pd[128 + e]));
        float ot = 0.f;
#pragma unroll
        for (int d4 = 0; d4 < 64; d4 += 4) { const f32x4 kv = *(const LAS f32x4*)(ks + t * 128 + 64 * half + d4); const f32x4 qv = *(const LAS f32x4*)(qs + t * 128 + 64 * half + d4);
#pragma unroll
            for (int i = 0; i < 4; ++i) { S[d4 + i] = a * S[d4 + i] + kv[i] * u; ot += qv[i] * S[d4 + i]; } }
        o[t] = ot;
        LDS_BARRIER();
    }
    float* so = C.out + O_SGDN + ((size_t)(l * 128 + b) * 4 + h) * 16384 + (size_t)(64 * half) * 128 + e;
#pragma unroll
    for (int d = 0; d < 64; ++d) __builtin_nontemporal_store(S[d], so + d * 128);
#pragma unroll
    for (int t = 0; t < 4; ++t) po[(half * 4 + t) * 128 + e] = o[t];
    LDS_BARRIER();
#pragma unroll
    for (int t = 0; t < 4; ++t) { o[t] = po[t * 128 + e] + po[(4 + t) * 128 + e]; const float a = wave_sum(o[t] * o[t]); if (lane == 0 && half == 0) red[wsub * 12 + t] = a; }
    LDS_BARRIER();
    if (half == 0) {
        const float nw = C.gdn_norm_w()[l * 128 + e];
#pragma unroll
        for (int t = 0; t < 4; ++t) {
            const float rstd = __builtin_amdgcn_rsqf((red[t] + red[12 + t]) * (1.0f / 128.0f) + EPS);
            const float z = bf2f(C.gz()[(row0 + t) * 512 + h * 128 + e]);
            C.mix()[(row0 + t) * DM + h * 128 + e] = (bf16_t)f2bf(o[t] * rstd * nw * silu_f(z));
        }
    }
    LDS_BARRIER();
}

constexpr int MS_SC = 0  , MS_Q = 32768  , MS_GATE = 33792  , MS_OWN = 33920  , MS_ML = 33984  ,
              MS_RED = 34048  , MS_ORED = 34304  , MS_STG = 42496  ;
__device__ __forceinline__ void moba_sample_item(const Ctx& C, const int tid0, int l, int item, LAS unsigned char* lds) {
    const int tid = tid0, lane = tid & 63, w = tid >> 6, sub = tid & 15, kidx = tid >> 4;
    const int b = item >> 2, h = item & 3;
    LAS float* sc = (LAS float*)(lds + MS_SC);
    LAS float* qv = (LAS float*)(lds + MS_Q);
    LAS float* gate = (LAS float*)(lds + MS_GATE);
    LAS float* own = (LAS float*)(lds + MS_OWN);
    LAS float* ml = (LAS float*)(lds + MS_ML);
    LAS float* red = (LAS float*)(lds + MS_RED);
    LAS float* ored = (LAS float*)(lds + MS_ORED);
    const size_t sbase = (size_t)MP * 256 + (size_t)(b * 4 + h) * 4 * 64;
    if (tid < 256) qv[tid] = bf2f(C.mq()[sbase + tid]);
    LDS_BARRIER();
    const int* ptab = C.page_table() + b * NPAGES;
    const float* kc = C.cache_k() + (size_t)l * NPOOL * 128 * 256;
    {
        const int g4 = lane >> 4, l15 = lane & 15;
        bf16x8 bq[2];
#pragma unroll
        for (int ks = 0; ks < 2; ++ks) {
            u32x4 o = {0u, 0u, 0u, 0u};
            if (l15 < 4) { const f32x4 a0 = *(const LAS f32x4*)(qv + l15 * 64 + 32 * ks + 4 * g4), a1 = *(const LAS f32x4*)(qv + l15 * 64 + 32 * ks + 16 + 4 * g4);
                o.x = pk2(a0[0], a0[1]); o.y = pk2(a0[2], a0[3]); o.z = pk2(a1[0], a1[1]); o.w = pk2(a1[2], a1[3]); }
            bq[ks] = __builtin_bit_cast(bf16x8, o);
        }
        f32x4 kfA[4][4], kfB[4][4];
#define MS_LOAD(KF, T0) do { _Pragma("unroll") for (int u = 0; u < 4; ++u) { const int p = 16 * ((T0) + 8 * u) + l15; const int page = ptab[p >> 7]; \
            const float* kp = kc + (((size_t)page * 128 + (p & 127)) * 4 + h) * 64 + 4 * g4; \
            KF[u][0] = __builtin_nontemporal_load((const f32x4*)kp); KF[u][1] = __builtin_nontemporal_load((const f32x4*)(kp + 16)); \
            KF[u][2] = __builtin_nontemporal_load((const f32x4*)(kp + 32)); KF[u][3] = __builtin_nontemporal_load((const f32x4*)(kp + 48)); } } while (0)
#define MS_COMP(KF, T0) do { _Pragma("unroll") for (int u = 0; u < 4; ++u) { f32x4 acc = {0.f, 0.f, 0.f, 0.f}; \
            _Pragma("unroll") for (int ks = 0; ks < 2; ++ks) { u32x4 o; o.x = pk2(KF[u][2 * ks][0], KF[u][2 * ks][1]); o.y = pk2(KF[u][2 * ks][2], KF[u][2 * ks][3]); o.z = pk2(KF[u][2 * ks + 1][0], KF[u][2 * ks + 1][1]); o.w = pk2(KF[u][2 * ks + 1][2], KF[u][2 * ks + 1][3]); \
                acc = MFMA16(__builtin_bit_cast(bf16x8, o), bq[ks], acc); } \
            if (l15 < 4) { *(LAS f32x4*)(sc + l15 * 2048 + 16 * ((T0) + 8 * u) + 4 * g4) = acc; } } } while (0)
        MS_LOAD(kfA, w); MS_LOAD(kfB, w + 32);
        MS_COMP(kfA, w); MS_LOAD(kfA, w + 64);
        MS_COMP(kfB, w + 32); MS_LOAD(kfB, w + 96);
        MS_COMP(kfA, w + 64); MS_COMP(kfB, w + 96);
#undef MS_LOAD
#undef MS_COMP
    }
    if (tid < 256) { const int pr = tid >> 4, q = pr >> 2, tp = pr & 3; float s = 0.f;
#pragma unroll
        for (int i = 0; i < 4; ++i) s += qv[q * 64 + 4 * sub + i] * bf2f(C.mk()[sbase + tp * 64 + 4 * sub + i]);
        s += __shfl_xor(s, 1); s += __shfl_xor(s, 2); s += __shfl_xor(s, 4); s += __shfl_xor(s, 8);
        if (sub == 0) own[pr] = s; }
    LDS_BARRIER();
#pragma unroll
    for (int pi = 0; pi < 4; ++pi) { const int pr = 4 * w + pi, q = pr >> 3, j = pr & 7; float s = 0.f;
#pragma unroll
        for (int i = 0; i < 4; ++i) s += sc[q * 2048 + 256 * j + lane + 64 * i];
        s = wave_sum(s); if (lane == 0) gate[q * 8 + j] = s * (1.0f / 256.0f); }
    LDS_BARRIER();
    if (tid < 64) { const int q = (tid >> 3) & 3, j = tid & 7; int rank = 0; const float gj = gate[q * 8 + j];
#pragma unroll
        for (int i = 0; i < 8; ++i) { const float gi = gate[q * 8 + i]; rank += (i != j && (gi > gj || (gi == gj && i < j))) ? 1 : 0; }
        const unsigned long long bal = __ballot(rank < 3);
        if (tid < 32 && j == 0) ((LAS unsigned*)ml)[8 + q] = (unsigned)(bal >> (8 * q)) & 0xffu; }
    LDS_BARRIER();
    unsigned selq[4];
#pragma unroll
    for (int q = 0; q < 4; ++q) selq[q] = ((LAS unsigned*)ml)[8 + q];
    unsigned vmask = selq[0] | selq[1] | selq[2] | selq[3];
    const float* vc = C.cache_v() + (size_t)l * NPOOL * 128 * 256;
    f32x4 vA[8], vB[8];
#define MS_LOADV(VV, J) do { _Pragma("unroll") for (int i = 0; i < 8; ++i) { const int p = 256 * (J) + kidx + 32 * i; const int page = ptab[p >> 7]; \
        VV[i] = __builtin_nontemporal_load((const f32x4*)(vc + (((size_t)page * 128 + (p & 127)) * 4 + h) * 64 + 4 * sub)); } } while (0)
    int jA = __builtin_ctz(vmask); vmask &= vmask - 1u; MS_LOADV(vA, jA);
    int jB = __builtin_ctz(vmask); vmask &= vmask - 1u; MS_LOADV(vB, jB);
    {
        const int q = w >> 1, hf = w & 1; const unsigned sel = ((LAS unsigned*)ml)[8 + q];
        int blk[3]; { int n = 0;
#pragma unroll
            for (int j = 0; j < 8; ++j) if ((sel >> j) & 1u) { if (n == 0) blk[0] = j; else if (n == 1) blk[1] = j; else blk[2] = j; ++n; } }
        float vals[6];
        float mx = -1e30f;
#pragma unroll
        for (int i = 0; i < 6; ++i) { const int idx = hf * 384 + lane + 64 * i; const int sl = idx >> 8; const int bj = (sl == 0) ? blk[0] : (sl == 1 ? blk[1] : blk[2]);
            vals[i] = sc[q * 2048 + 256 * bj + (idx & 255)]; mx = fmaxf(mx, vals[i]); }
        float ov = -1e30f;
        if (hf == 0 && lane <= q) { ov = own[q * 4 + lane]; mx = fmaxf(mx, ov); }
        mx = wave_max(mx);
        if (lane == 0) red[w * 2] = mx;
        LDS_BARRIER();
        const float m = fmaxf(red[(w & ~1) * 2], red[(w | 1) * 2]);
        float s = 0.f;
#pragma unroll
        for (int i = 0; i < 6; ++i) s += __expf(vals[i] - m);
        if (hf == 0 && lane <= q) s += __expf(ov - m);
        s = wave_sum(s);
        if (lane == 0) red[w * 2 + 1] = s;
        LDS_BARRIER();
        if (lane == 0 && hf == 0) { ml[q] = m; ml[4 + q] = red[w * 2 + 1] + red[(w + 1) * 2 + 1]; }
    }
    LDS_BARRIER();
    f32x4 acc[4];
#pragma unroll
    for (int q = 0; q < 4; ++q) acc[q] = (f32x4){0.f, 0.f, 0.f, 0.f};
    float mq_[4];
#pragma unroll
    for (int q = 0; q < 4; ++q) mq_[q] = ml[q];
#define MS_COMPV(VV, J) do { _Pragma("unroll") for (int i = 0; i < 8; ++i) { const int p = 256 * (J) + kidx + 32 * i; \
        _Pragma("unroll") for (int q = 0; q < 4; ++q) { const float wgt = ((selq[q] >> (J)) & 1u) ? __expf(sc[q * 2048 + p] - mq_[q]) : 0.f; acc[q] = acc[q] + VV[i] * wgt; } } } while (0)
    for (;;) {
        MS_COMPV(vA, jA);
        if (vmask) { jA = __builtin_ctz(vmask); vmask &= vmask - 1u; MS_LOADV(vA, jA); } else jA = -1;
        if (jB < 0) break;
        MS_COMPV(vB, jB);
        if (vmask) { jB = __builtin_ctz(vmask); vmask &= vmask - 1u; MS_LOADV(vB, jB); } else jB = -1;
        if (jA < 0) break;
    }
#undef MS_LOADV
#undef MS_COMPV
    if (kidx < 4) {
        const bf16_t* vp = C.mv() + sbase + kidx * 64 + 4 * sub;
        const f32x4 vn = {bf2f(vp[0]), bf2f(vp[1]), bf2f(vp[2]), bf2f(vp[3])};
#pragma unroll
        for (int q = 0; q < 4; ++q) { const float wgt = (kidx <= q) ? __expf(own[q * 4 + kidx] - mq_[q]) : 0.f; acc[q] = acc[q] + vn * wgt; }
    }
#pragma unroll
    for (int q = 0; q < 4; ++q)
#pragma unroll
        for (int i = 0; i < 4; ++i) { float v = acc[q][i]; v += __shfl_xor(v, 16); v += __shfl_xor(v, 32); acc[q][i] = v; }
    if (lane < 16) {
#pragma unroll
        for (int q = 0; q < 4; ++q) *(LAS f32x4*)(ored + (w * 4 + q) * 64 + 4 * sub) = acc[q];
    }
    LDS_BARRIER();
    if (tid < 256) { const int q = tid >> 6, d = tid & 63; float s = 0.f;
#pragma unroll
        for (int ww = 0; ww < 8; ++ww) s += ored[(ww * 4 + q) * 64 + d];
        C.mix()[((size_t)MP + 4 * b + q) * DM + 768 + h * 64 + d] = (bf16_t)f2bf(s / ml[4 + q]); }
    LDS_BARRIER();
}

__device__ __forceinline__ void final_norm(const Ctx& C, const int tid0) {
    const int tid = tid0, lane = tid & 63, wave = tid >> 6;
    const int gw = C.wg * 8 + wave, NGW = C.G * 8;
    constexpr int U = 3;
    for (int m0 = gw; m0 < MT; m0 += U * NGW) {
        u32x2 xo[U][4];
#pragma unroll
        for (int k = 0; k < U; ++k) { const int m = m0 + k * NGW;
#pragma unroll
            for (int j = 0; j < 4; ++j) { xo[k][j] = (u32x2){0u, 0u}; if (m < MT) xo[k][j] = *(const u32x2*)(C.xb() + (size_t)m * DM + 4 * lane + 256 * j); } }
#pragma unroll
        for (int k = 0; k < U; ++k) { const int m = m0 + k * NGW;
            if (m < MT) {
                f32x4 v[4]; float ss = 0.f;
#pragma unroll
                for (int j = 0; j < 4; ++j) { v[j] = (f32x4){bf2f(xo[k][j].x & 0xffffu), bf2f(xo[k][j].x >> 16), bf2f(xo[k][j].y & 0xffffu), bf2f(xo[k][j].y >> 16)};
                    ss += (v[j][0] * v[j][0] + v[j][1] * v[j][1]) + (v[j][2] * v[j][2] + v[j][3] * v[j][3]); }
                const float rs = __builtin_amdgcn_rsqf(wave_sum(ss) * (1.0f / 1024.0f) + EPS);
                float* o = C.out + ((m < MP) ? (O_YP + (size_t)m * DM) : (O_YS + (size_t)(m - MP) * DM));
#pragma unroll
                for (int j = 0; j < 4; ++j) { const f32x4 nw = *(const f32x4*)(C.norm_final() + 4 * lane + 256 * j); *(f32x4*)(o + 4 * lane + 256 * j) = v[j] * rs * nw; }
            }
        }
    }
}

struct HalfBar { LAS unsigned* slots; unsigned gen; int w; };
__device__ __forceinline__ void hb_sync(HalfBar& hb, const int lane) {
    (void)lane;
    hb.gen += 1u;
    unsigned t0, t1, t2, t3, ts; unsigned long long sv;
    const unsigned addr = (unsigned)(size_t)hb.slots, own = addr + 4u * (unsigned)hb.w;
    asm volatile("s_waitcnt lgkmcnt(0)\n\t"
                 "s_mov_b64 %[sv], exec\n\t"
                 "s_mov_b64 exec, 1\n\t"
                 "ds_write_b32 %[own], %[gv]\n"
                 "1:\n\t"
                 "ds_read_b32 %[t0], %[ad]\n\t"
                 "ds_read_b32 %[t1], %[ad] offset:4\n\t"
                 "ds_read_b32 %[t2], %[ad] offset:8\n\t"
                 "ds_read_b32 %[t3], %[ad] offset:12\n\t"
                 "s_waitcnt lgkmcnt(0)\n\t"
                 "v_min_u32 %[t0], %[t0], %[t1]\n\t"
                 "v_min_u32 %[t2], %[t2], %[t3]\n\t"
                 "v_min_u32 %[t0], %[t0], %[t2]\n\t"
                 "s_nop 1\n\t"
                 "v_readfirstlane_b32 %[ts], %[t0]\n\t"
                 "s_cmp_ge_u32 %[ts], %[gs]\n\t"
                 "s_cbranch_scc1 2f\n\t"
                 "s_sleep 1\n\t"
                 "s_branch 1b\n"
                 "2:\n\t"
                 "s_mov_b64 exec, %[sv]"
                 : [t0] "=&v"(t0), [t1] "=&v"(t1), [t2] "=&v"(t2), [t3] "=&v"(t3), [ts] "=&s"(ts), [sv] "=&s"(sv)
                 : [ad] "v"(addr), [own] "v"(own), [gv] "v"(hb.gen), [gs] "s"(hb.gen) : "memory", "scc");
}
__device__ __forceinline__ void hb_sync_cpp(HalfBar& hb) {
    __builtin_amdgcn_fence(__ATOMIC_RELEASE, "workgroup");
    hb.gen += 1u;
    volatile LAS unsigned* sl = (volatile LAS unsigned*)hb.slots;
    sl[hb.w] = hb.gen;
    for (;;) { const unsigned a = sl[0], b = sl[1], c = sl[2], d = sl[3]; const unsigned m = min(min(a, b), min(c, d)); if (__builtin_amdgcn_readfirstlane((int)m) >= (int)hb.gen) break; __builtin_amdgcn_s_sleep(1); }
    __builtin_amdgcn_fence(__ATOMIC_ACQUIRE, "workgroup");
}
#ifndef MS_BT
#define MS_BT 2
#endif
#ifndef HB_G1
#define HB_G1 1
#endif
#ifndef HB_KM
#define HB_KM 1
#endif
#ifndef HB_MS
#define HB_MS 1
#endif
#ifndef HB_GS
#define HB_GS 1
#endif
#define HBS_SEL(f) do { if ((f) == 1) hb_sync(hb, lane); else if ((f) == 2) { LDS_BARRIER(); hb_sync(hb, lane); } else if ((f) == 3) hb_sync_cpp(hb); else if ((f) == 4) { hb_sync(hb, lane); hb_sync(hb, lane); } else LDS_BARRIER(); } while (0)

constexpr int H1_KN = 0, H1_VB = 18432, H1_KT = 36864, H1_QN = 55296, H1_LM = 73728, H1_TM = 91136, H1_LB = 100352, H1_SC = 109568, H1_WU2 = 55296  , H_B = 110592;

__device__ __forceinline__ void g1h_chunk(const Ctx& C, const int tl, int l, int item, LAS unsigned char* lds, HalfBar& hb) {
    const int lane = tl & 63, w = tl >> 6, g4 = lane >> 4, l15 = lane & 15;
    const int b = item >> 7, h = (item >> 5) & 3, c = item & 31;
    const int grow0 = b * SEQ + 64 * c;
    LAS float* scal = (LAS float*)(lds + H1_SC);
    LAS float* LM = (LAS float*)(lds + H1_LM);
    const int dcol = h * 128 + 2 * lane;
    unsigned rowq[19], rowk[19], rowv[19];
#pragma unroll
    for (int j = 0; j < 19; ++j) {
        const int p = 16 * w - 3 + j;
        rowq[j] = 0u; rowk[j] = 0u; rowv[j] = 0u;
        if (c > 0 || p >= 0) { const bf16_t* rp = C.gqkv() + (size_t)(grow0 + p) * 1536 + dcol; rowq[j] = *(const unsigned*)rp; rowk[j] = *(const unsigned*)(rp + 512); rowv[j] = *(const unsigned*)(rp + 1024); }
    }
    float a_gc, a_bet, a_eg, a_ek;
    {
        const float* ba = C.ba() + (size_t)(grow0 + lane) * 8;
        a_bet = ba[h];
        float x = ba[4 + h];
#pragma unroll
        for (int d = 1; d < 64; d <<= 1) { const float t = __shfl_up(x, d); if (lane >= d) x += t; }
        const float gl = __builtin_bit_cast(float, __builtin_amdgcn_readlane(__builtin_bit_cast(int, x), 63));
        a_gc = x; a_eg = __expf(x); a_ek = __expf(gl - x);
        if (w == 0) { scal[lane] = a_gc; scal[64 + lane] = a_bet; scal[128 + lane] = a_eg; scal[192 + lane] = a_ek; if (lane == 0) C.gcd()[item] = __expf(gl); }
    }
    {
        const float* cw = C.gdn_conv_w() + (size_t)l * 4 * 1536;
        float wq[4][2], wk[4][2], wv[4][2];
#pragma unroll
        for (int tp = 0; tp < 4; ++tp) { wq[tp][0] = cw[tp * 1536 + dcol]; wq[tp][1] = cw[tp * 1536 + dcol + 1]; wk[tp][0] = cw[tp * 1536 + 512 + dcol]; wk[tp][1] = cw[tp * 1536 + 512 + dcol + 1];
            wv[tp][0] = cw[tp * 1536 + 1024 + dcol]; wv[tp][1] = cw[tp * 1536 + 1024 + dcol + 1]; }
        float rq[3][2], rk[3][2], rv[3][2];
#pragma unroll
        for (int j = 0; j < 3; ++j) {
            const unsigned uq = rowq[j], uk = rowk[j], uv = rowv[j];
            rq[j][0] = bf2f(uq & 0xffffu); rq[j][1] = bf2f(uq >> 16); rk[j][0] = bf2f(uk & 0xffffu); rk[j][1] = bf2f(uk >> 16); rv[j][0] = bf2f(uv & 0xffffu); rv[j][1] = bf2f(uv >> 16);
        }
#pragma unroll
        for (int i = 0; i < 16; ++i) {
            const int p = 16 * w + i;
            const unsigned uq = rowq[3 + i], uk = rowk[3 + i], uv = rowv[3 + i];
            float cq[2] = {bf2f(uq & 0xffffu), bf2f(uq >> 16)}, ck[2] = {bf2f(uk & 0xffffu), bf2f(uk >> 16)}, cv[2] = {bf2f(uv & 0xffffu), bf2f(uv >> 16)};
            float yq[2], yk[2], yv[2];
#pragma unroll
            for (int e = 0; e < 2; ++e) {
                yq[e] = silu_f(wq[0][e] * rq[0][e] + wq[1][e] * rq[1][e] + wq[2][e] * rq[2][e] + wq[3][e] * cq[e]);
                yk[e] = silu_f(wk[0][e] * rk[0][e] + wk[1][e] * rk[1][e] + wk[2][e] * rk[2][e] + wk[3][e] * ck[e]);
                yv[e] = silu_f(wv[0][e] * rv[0][e] + wv[1][e] * rv[1][e] + wv[2][e] * rv[2][e] + wv[3][e] * cv[e]);
                rq[0][e] = rq[1][e]; rq[1][e] = rq[2][e]; rq[2][e] = cq[e];
                rk[0][e] = rk[1][e]; rk[1][e] = rk[2][e]; rk[2][e] = ck[e];
                rv[0][e] = rv[1][e]; rv[1][e] = rv[2][e]; rv[2][e] = cv[e];
            }
            const float sq = wave_sum(yq[0] * yq[0] + yq[1] * yq[1]), sk = wave_sum(yk[0] * yk[0] + yk[1] * yk[1]);
            const float nq = __builtin_amdgcn_rsqf(sq + EPS) * 0.08838834764831845f, nk = __builtin_amdgcn_rsqf(sk + EPS);
            const float bet = __builtin_bit_cast(float, __builtin_amdgcn_readlane(__builtin_bit_cast(int, a_bet), p)), eg = __builtin_bit_cast(float, __builtin_amdgcn_readlane(__builtin_bit_cast(int, a_eg), p)), ek = __builtin_bit_cast(float, __builtin_amdgcn_readlane(__builtin_bit_cast(int, a_ek), p));
            const float q0 = yq[0] * nq, q1 = yq[1] * nq, k0 = yk[0] * nk, k1 = yk[1] * nk;
            const int o = p * G1_ST + 4 * lane;
            *(LAS unsigned*)(lds + H1_KN + o) = pk2(k0, k1);
            *(LAS unsigned*)(lds + H1_QN + o) = pk2(q0, q1);
            *(LAS unsigned*)(lds + H1_VB + o) = pk2(yv[0] * bet, yv[1] * bet);
            *(LAS unsigned*)(lds + H1_KT + o) = pk2(k0 * ek, k1 * ek);
            *(unsigned*)(C.gqd() + ((size_t)item * 64 + p) * 128 + 2 * lane) = pk2(q0 * eg, q1 * eg);
        }
    }
    HBS_SEL(HB_G1);
    {
        int lane_c = lane; asm volatile("" : "+v"(lane_c));
        const int lane = lane_c, g4 = lane >> 4, l15 = lane & 15;
        const int it = w;
        bf16x8 af[4];
#pragma unroll
        for (int ks = 0; ks < 4; ++ks) af[ks] = *(const LAS bf16x8*)(lds + H1_KN + (16 * it + l15) * G1_ST + (32 * ks + 8 * g4) * 2);
        for (int jt = 0; jt <= it; ++jt) {
            f32x4 acc = {0.f, 0.f, 0.f, 0.f};
#pragma unroll
            for (int ks = 0; ks < 4; ++ks) { const bf16x8 bfr = *(const LAS bf16x8*)(lds + H1_KN + (16 * jt + l15) * G1_ST + (32 * ks + 8 * g4) * 2); acc = MFMA16(af[ks], bfr, acc); }
            const int j = 16 * jt + l15; const float gj = scal[j];
#pragma unroll
            for (int r = 0; r < 4; ++r) { const int i = 16 * it + 4 * g4 + r; const float lv = (i > j) ? scal[64 + i] * acc[r] * __expf(scal[i] - gj) : 0.f; LM[i * 68 + j] = lv; *(LAS bf16_t*)(lds + H1_LB + i * G1_TMST + j * 2) = (bf16_t)f2bf(lv); }
        }
        bf16x8 bq[4];
#pragma unroll
        for (int ks = 0; ks < 4; ++ks) bq[ks] = *(const LAS bf16x8*)(lds + H1_QN + (16 * it + l15) * G1_ST + (32 * ks + 8 * g4) * 2);
        const int i = 16 * it + l15; const float gi = scal[i];
#pragma unroll
        for (int jt = 0; jt < 4; ++jt) {
            f32x4 acc = {0.f, 0.f, 0.f, 0.f};
#pragma unroll
            for (int ks = 0; ks < 4; ++ks) { const bf16x8 ak = *(const LAS bf16x8*)(lds + H1_KN + (16 * jt + l15) * G1_ST + (32 * ks + 8 * g4) * 2); acc = MFMA16(ak, bq[ks], acc); }
            float v[4];
#pragma unroll
            for (int r = 0; r < 4; ++r) { const int j = 16 * jt + 4 * g4 + r; v[r] = (i >= j) ? acc[r] * __expf(gi - scal[j]) : 0.f; }
            u32x2 o; o.x = pk2(v[0], v[1]); o.y = pk2(v[2], v[3]);
            *(u32x2*)(C.gatt() + ((size_t)item * 64 + i) * 64 + 16 * jt + 4 * g4) = o;
        }
    }
    if (lane < 16) {
        int lane_d = lane; asm volatile("" : "+v"(lane_d));
        const int d = w, cc = lane_d & 15;
        const LAS float* Ld = LM + (16 * d) * 68 + 16 * d;
        float t[16];
#pragma unroll
        for (int i = 0; i < 16; ++i) {
            float s0 = 0.f, s1 = 0.f;
#pragma unroll
            for (int j4 = 0; j4 < i; j4 += 4) {
                const f32x4 Lv = *(const LAS f32x4*)(Ld + i * 68 + j4);
                if (j4 + 0 < i) s0 += Lv[0] * t[j4 + 0];
                if (j4 + 1 < i) s1 += Lv[1] * t[j4 + 1];
                if (j4 + 2 < i) s0 += Lv[2] * t[j4 + 2];
                if (j4 + 3 < i) s1 += Lv[3] * t[j4 + 3];
            }
            t[i] = ((cc == i) ? 1.f : 0.f) - (s0 + s1);
        }
#pragma unroll
        for (int i = 0; i < 16; ++i) *(LAS bf16_t*)(lds + H1_TM + (16 * d + i) * G1_TMST + (16 * d + cc) * 2) = (bf16_t)f2bf(t[i]);
    }
    HBS_SEL(HB_G1);
    {
        int lane_e = lane; asm volatile("" : "+v"(lane_e));
        const int lane = lane_e, g4 = lane >> 4, l15 = lane & 15;
#pragma unroll
        for (int bi = 0; bi < 4; ++bi) {
            u32x2 tdiag = *(const LAS u32x2*)(lds + H1_TM + (16 * bi + l15) * G1_TMST + (16 * bi + 4 * g4) * 2);
            u32x4 ta4; ta4.x = tdiag.x; ta4.y = tdiag.y; ta4.z = 0u; ta4.w = 0u;
            const bf16x8 tA = __builtin_bit_cast(bf16x8, ta4);
            float rsc[4];
#pragma unroll
            for (int e = 0; e < 4; ++e) { const int pos = 16 * bi + 4 * g4 + e; rsc[e] = (w < 2) ? scal[64 + pos] * scal[128 + pos] : 1.0f; }
#pragma unroll
            for (int cq = 0; cq < 4; ++cq) {
                const int ct = 4 * w + cq, feat = 16 * ct + l15;
                const LAS unsigned char* img = lds + (w < 2 ? H1_KN : H1_VB);
                const int col = 16 * (ct & 7) + l15;
                f32x4 y;
#pragma unroll
                for (int e = 0; e < 4; ++e) y[e] = bf2f(*(const LAS bf16_t*)(img + (16 * bi + 4 * g4 + e) * G1_ST + col * 2)) * rsc[e];
                if (bi > 0) {
                    f32x4 pacc = {0.f, 0.f, 0.f, 0.f};
#pragma unroll
                    for (int s2 = 0; s2 < (bi + 1) / 2; ++s2) {
                        const bool valid = (32 * s2 + 8 * g4) < 16 * bi;
                        u32x4 la = *(const LAS u32x4*)(lds + H1_LB + (16 * bi + l15) * G1_TMST + (32 * s2 + 8 * g4) * 2);
                        u32x4 xb = __builtin_bit_cast(u32x4, tr_frag(lds + H1_WU2, G1_WUST, 32 * s2 + 8 * g4, 32 * s2 + 8 * g4 + 4, 16 * ct, lane));
                        if (!valid) { la = (u32x4){0u, 0u, 0u, 0u}; xb = (u32x4){0u, 0u, 0u, 0u}; }
                        pacc = MFMA16(__builtin_bit_cast(bf16x8, la), __builtin_bit_cast(bf16x8, xb), pacc);
                    }
                    y = y - pacc;
                }
                u32x4 yb; yb.x = pk2(y[0], y[1]); yb.y = pk2(y[2], y[3]); yb.z = 0u; yb.w = 0u;
                const f32x4 x = MFMA16(tA, __builtin_bit_cast(bf16x8, yb), ((f32x4){0.f, 0.f, 0.f, 0.f}));
#pragma unroll
                for (int e = 0; e < 4; ++e) { const int pos = 16 * bi + 4 * g4 + e; *(LAS bf16_t*)(lds + H1_WU2 + pos * G1_WUST + feat * 2) = (bf16_t)f2bf(x[e]); }
            }
        }
    }
    HBS_SEL(HB_G1);
    {
        int tl_e = tl; asm volatile("" : "+v"(tl_e));
        const int pos = tl_e >> 2, ch = tl_e & 3;
        bf16_t* wrow = C.gw() + ((size_t)item * 64 + pos) * 128;
        bf16_t* urow = (bf16_t*)C.gu() + ((size_t)item * 64 + pos) * 128;
        const LAS unsigned char* src = lds + H1_WU2 + pos * G1_WUST;
#pragma unroll
        for (int k = 0; k < 4; ++k) { const int chunk = ch + 4 * k; *(u32x4*)(wrow + chunk * 8) = *(const LAS u32x4*)(src + chunk * 16); *(u32x4*)(urow + chunk * 8) = *(const LAS u32x4*)(src + 256 + chunk * 16); }
    }
    {
        int lane_f = lane; asm volatile("" : "+v"(lane_f));
        const int lane = lane_f, g4 = lane >> 4, l15 = lane & 15;
#pragma unroll
        for (int hh = 0; hh < 2; ++hh) {
            const int tt = 2 * w + hh;
            bf16x8 wa[2], ka[2];
#pragma unroll
            for (int ks = 0; ks < 2; ++ks) { wa[ks] = tr_frag(lds + H1_WU2, G1_WUST, 32 * ks + 8 * g4, 32 * ks + 8 * g4 + 4, 16 * tt, lane);
                                             ka[ks] = tr_frag(lds + H1_KT, G1_ST, 32 * ks + 8 * g4, 32 * ks + 8 * g4 + 4, 16 * tt, lane); }
#pragma unroll
            for (int at = 0; at < 8; ++at) {
                f32x4 acc = {0.f, 0.f, 0.f, 0.f};
#pragma unroll
                for (int ks = 0; ks < 2; ++ks) { const bf16x8 kb = tr_frag(lds + H1_KT, G1_ST, 32 * ks + 8 * g4, 32 * ks + 8 * g4 + 4, 16 * at, lane); acc = MFMA16(wa[ks], kb, acc); }
                u32x2 o; o.x = pk2(-acc[0], -acc[1]); o.y = pk2(-acc[2], -acc[3]);
                *(u32x2*)(C.gap() + ((size_t)item * 128 + 16 * at + l15) * 128 + 32 * (tt >> 1) + 8 * g4 + 4 * (tt & 1)) = o;
            }
#pragma unroll
            for (int et = 0; et < 8; ++et) {
                f32x4 acc = {0.f, 0.f, 0.f, 0.f};
#pragma unroll
                for (int ks = 0; ks < 2; ++ks) { const bf16x8 ub = tr_frag(lds + H1_WU2, G1_WUST, 32 * ks + 8 * g4, 32 * ks + 8 * g4 + 4, 128 + 16 * et, lane); acc = MFMA16(ka[ks], ub, acc); }
                { u32x2 o; o.x = pk2(acc[0], acc[1]); o.y = pk2(acc[2], acc[3]); *(u32x2*)((bf16_t*)C.gbc() + ((((size_t)item * 8 + et) * 8 + tt) * 64 + lane) * 4) = o; }
            }
        }
    }
    HBS_SEL(HB_G1);
}

__device__ __forceinline__ void gs4_item(const Ctx& C, const int tl, int l, int item, LAS unsigned char* lds, HalfBar& hb) {
    const int grp = 0, e = tl & 127, half = tl >> 7, lane = tl & 63, wsub = (tl >> 6) & 1;
    const int b = item >> 2, h = item & 3;
    LAS float* ks = (LAS float*)(lds + grp * 16384);
    LAS float* qs = ks + 512;
    LAS float* pd = qs + 512;
    LAS float* po = pd + 1024;
    LAS float* red = po + 1024;
    const size_t row0 = (size_t)MP + 4 * b;
    float S[64];
    const float* sp = C.state_gdn() + ((size_t)(l * 128 + b) * 4 + h) * 16384 + (size_t)(64 * half) * 128 + e;
#pragma unroll
    for (int d = 0; d < 64; ++d) S[d] = __builtin_nontemporal_load(sp + d * 128);
    float bet_[4], alog_[4], zv_[4];
#pragma unroll
    for (int t = 0; t < 4; ++t) { const float* bap = C.ba() + (row0 + t) * 8; bet_[t] = bap[h]; alog_[t] = bap[4 + h]; zv_[t] = bf2f(C.gz()[(row0 + t) * 512 + h * 128 + e]); }
    const float nw_ = C.gdn_norm_w()[l * 128 + e];
    float yq[4], yk[4], yv[4];
    {
        const float* cw = C.gdn_conv_w() + (size_t)l * 4 * 1536;
        const int col = h * 128 + e;
        float xq[7], xk[7], xv[7];
#pragma unroll
        for (int j = 0; j < 3; ++j) { const float* hp = C.state_gdn_conv() + ((size_t)(l * 128 + b) * 3 + j) * 1536 + col; xq[j] = hp[0]; xk[j] = hp[512]; xv[j] = hp[1024]; }
#pragma unroll
        for (int t = 0; t < 4; ++t) { const bf16_t* rp = C.gqkv() + (row0 + t) * 1536 + col; xq[3 + t] = bf2f(rp[0]); xk[3 + t] = bf2f(rp[512]); xv[3 + t] = bf2f(rp[1024]); }
#pragma unroll
        for (int t = 0; t < 4; ++t) {
            float aq = 0.f, ak = 0.f, av = 0.f;
#pragma unroll
            for (int i = 0; i < 4; ++i) { aq += cw[i * 1536 + col] * xq[t + i]; ak += cw[i * 1536 + 512 + col] * xk[t + i]; av += cw[i * 1536 + 1024 + col] * xv[t + i]; }
            yq[t] = silu_f(aq); yk[t] = silu_f(ak); yv[t] = silu_f(av);
        }
    }
#pragma unroll
    for (int t = 0; t < 4; ++t) { const float a = wave_sum(yq[t] * yq[t]), bb = wave_sum(yk[t] * yk[t]); if (lane == 0 && half == 0) { red[wsub * 12 + t] = a; red[wsub * 12 + 4 + t] = bb; } }
    HBS_SEL(HB_GS);
    if (half == 0) {
#pragma unroll
        for (int t = 0; t < 4; ++t) {
            const float sq = red[t] + red[12 + t], sk = red[4 + t] + red[16 + t];
            qs[t * 128 + e] = yq[t] * __builtin_amdgcn_rsqf(sq + EPS) * 0.08838834764831845f;
            ks[t * 128 + e] = yk[t] * __builtin_amdgcn_rsqf(sk + EPS);
        }
    }
    HBS_SEL(HB_GS);
    float o[4];
#pragma unroll
    for (int t = 0; t < 4; ++t) {
        const float bet = bet_[t], a = __expf(alog_[t]);
        float dot = 0.f;
#pragma unroll
        for (int d4 = 0; d4 < 64; d4 += 4) { const f32x4 kv = *(const LAS f32x4*)(ks + t * 128 + 64 * half + d4); dot += (kv[0] * S[d4] + kv[1] * S[d4 + 1]) + (kv[2] * S[d4 + 2] + kv[3] * S[d4 + 3]); }
        pd[t * 256 + half * 128 + e] = dot;
        HBS_SEL(HB_GS);
        const float u = bet * (yv[t] - a * (pd[t * 256 + e] + pd[t * 256 + 128 + e]));
        float ot = 0.f;
#pragma unroll
        for (int d4 = 0; d4 < 64; d4 += 4) { const f32x4 kv = *(const LAS f32x4*)(ks + t * 128 + 64 * half + d4); const f32x4 qv = *(const LAS f32x4*)(qs + t * 128 + 64 * half + d4);
#pragma unroll
            for (int i = 0; i < 4; ++i) { S[d4 + i] = a * S[d4 + i] + kv[i] * u; ot += qv[i] * S[d4 + i]; } }
        o[t] = ot;
    }
    float* so = C.out + O_SGDN + ((size_t)(l * 128 + b) * 4 + h) * 16384 + (size_t)(64 * half) * 128 + e;
#pragma unroll
    for (int d = 0; d < 64; ++d) __builtin_nontemporal_store(S[d], so + d * 128);
#pragma unroll
    for (int t = 0; t < 4; ++t) po[(half * 4 + t) * 128 + e] = o[t];
    HBS_SEL(HB_GS);
#pragma unroll
    for (int t = 0; t < 4; ++t) { o[t] = po[t * 128 + e] + po[(4 + t) * 128 + e]; const float a = wave_sum(o[t] * o[t]); if (lane == 0 && half == 0) red[wsub * 12 + t] = a; }
    HBS_SEL(HB_GS);
    if (half == 0) {
        const float nw = nw_;
#pragma unroll
        for (int t = 0; t < 4; ++t) {
            const float rstd = __builtin_amdgcn_rsqf((red[t] + red[12 + t]) * (1.0f / 128.0f) + EPS);
            const float z = zv_[t];
            C.mix()[(row0 + t) * DM + h * 128 + e] = (bf16_t)f2bf(o[t] * rstd * nw * silu_f(z));
        }
    }
    HBS_SEL(HB_GS);
}

__device__ __forceinline__ void ms4_item(const Ctx& C, const int tl, int l, int item, LAS unsigned char* lds, HalfBar& hb) {
    const int tid = tl, lane = tid & 63, w = tid >> 6, sub = tid & 15, kidx = tid >> 4;
    const int b = item >> 2, h = item & 3;
    LAS float* sc = (LAS float*)(lds + MS_SC);
    LAS float* qv = (LAS float*)(lds + MS_Q);
    LAS float* gate = (LAS float*)(lds + MS_GATE);
    LAS float* own = (LAS float*)(lds + MS_OWN);
    LAS float* ml = (LAS float*)(lds + MS_ML);
    LAS float* red = (LAS float*)(lds + MS_RED);
    LAS float* ored = (LAS float*)(lds + MS_ORED);
    const size_t sbase = (size_t)MP * 256 + (size_t)(b * 4 + h) * 4 * 64;
    qv[tid] = bf2f(C.mq()[sbase + tid]);
    LAS int* ptl = (LAS int*)(lds + MS_STG + 9216);
    if (tid < NPAGES) ptl[tid] = C.page_table()[b * NPAGES + tid];
    HBS_SEL(HB_MS);
    const LAS int* ptab = ptl;
    const float* kc = C.cache_k() + (size_t)l * NPOOL * 128 * 256;
    {
        const int g4 = lane >> 4, l15 = lane & 15;
        bf16x8 bq[2];
#pragma unroll
        for (int ks = 0; ks < 2; ++ks) {
            u32x4 o = {0u, 0u, 0u, 0u};
            if (l15 < 4) { const f32x4 a0 = *(const LAS f32x4*)(qv + l15 * 64 + 32 * ks + 8 * g4), a1 = *(const LAS f32x4*)(qv + l15 * 64 + 32 * ks + 8 * g4 + 4);
                o.x = pk2(a0[0], a0[1]); o.y = pk2(a0[2], a0[3]); o.z = pk2(a1[0], a1[1]); o.w = pk2(a1[2], a1[3]); }
            bq[ks] = __builtin_bit_cast(bf16x8, o);
        }
        LAS unsigned char* stg = lds + MS_STG + w * 2304;
        f32x4 kfA[MS_BT][4], kfB[MS_BT][4];
#define MS_LOAD(KF, T0) do { _Pragma("unroll") for (int u = 0; u < MS_BT; ++u) { const int t_ = (T0) + 4 * u; const int page = ptab[t_ >> 3]; \
            const float* kp = kc + (((size_t)page * 128 + (16 * (t_ & 7) + g4)) * 4 + h) * 64 + 4 * l15; \
            KF[u][0] = __builtin_nontemporal_load((const f32x4*)kp); KF[u][1] = __builtin_nontemporal_load((const f32x4*)(kp + 4 * 256)); \
            KF[u][2] = __builtin_nontemporal_load((const f32x4*)(kp + 8 * 256)); KF[u][3] = __builtin_nontemporal_load((const f32x4*)(kp + 12 * 256)); } } while (0)
#define MS_COMP(KF, T0) do { _Pragma("unroll") for (int u = 0; u < MS_BT; ++u) { \
            _Pragma("unroll") for (int j = 0; j < 4; ++j) { u32x2 o; o.x = pk2(KF[u][j][0], KF[u][j][1]); o.y = pk2(KF[u][j][2], KF[u][j][3]); *(LAS u32x2*)(stg + (4 * j + g4) * 144 + l15 * 8) = o; } \
            f32x4 acc = {0.f, 0.f, 0.f, 0.f}; \
            _Pragma("unroll") for (int ks = 0; ks < 2; ++ks) { const bf16x8 a = *(const LAS bf16x8*)(stg + l15 * 144 + (32 * ks + 8 * g4) * 2); acc = MFMA16(a, bq[ks], acc); } \
            if (l15 < 4) { *(LAS f32x4*)(sc + l15 * 2048 + 16 * ((T0) + 4 * u) + 4 * g4) = acc; } } } while (0)
        constexpr int BS = 4 * MS_BT, NB2 = 128 / (2 * BS);
        MS_LOAD(kfA, w); MS_LOAD(kfB, w + BS);
        for (int k2 = 0; k2 < NB2 - 1; ++k2) { MS_COMP(kfA, w + 2 * BS * k2); MS_LOAD(kfA, w + 2 * BS * k2 + 2 * BS); MS_COMP(kfB, w + 2 * BS * k2 + BS); MS_LOAD(kfB, w + 2 * BS * k2 + 3 * BS); }
        MS_COMP(kfA, w + 2 * BS * (NB2 - 1)); MS_COMP(kfB, w + 2 * BS * (NB2 - 1) + BS);
#undef MS_LOAD
#undef MS_COMP
    }
    { const int pr = tid >> 4, q = pr >> 2, tp = pr & 3; float s = 0.f;
#pragma unroll
        for (int i = 0; i < 4; ++i) s += qv[q * 64 + 4 * sub + i] * bf2f(C.mk()[sbase + tp * 64 + 4 * sub + i]);
        s += __shfl_xor(s, 1); s += __shfl_xor(s, 2); s += __shfl_xor(s, 4); s += __shfl_xor(s, 8);
        if (sub == 0) own[pr] = s; }
    HBS_SEL(HB_MS);
    {
        float g[8];
#pragma unroll
        for (int j = 0; j < 8; ++j) { float s_ = 0.f;
#pragma unroll
            for (int i = 0; i < 4; ++i) s_ += sc[w * 2048 + 256 * j + lane + 64 * i];
            g[j] = wave_sum(s_) * (1.0f / 256.0f); }
        const int j = lane & 7;
        float gj = g[0];
#pragma unroll
        for (int i = 1; i < 8; ++i) gj = (j == i) ? g[i] : gj;
        int rank = 0;
#pragma unroll
        for (int i = 0; i < 8; ++i) rank += (i != j && (g[i] > gj || (g[i] == gj && i < j))) ? 1 : 0;
        const unsigned long long bal = __ballot(rank < 3);
        if (lane == 0) ((LAS unsigned*)ml)[8 + w] = (unsigned)bal & 0xffu;
    }
    HBS_SEL(HB_MS);
    unsigned selq[4];
#pragma unroll
    for (int q = 0; q < 4; ++q) selq[q] = ((LAS unsigned*)ml)[8 + q];
    unsigned vmask = selq[0] | selq[1] | selq[2] | selq[3];
    const float* vc = C.cache_v() + (size_t)l * NPOOL * 128 * 256;
    f32x4 vA[8], vB[8];
#define MS_LOADV(VV, J, HF) do { _Pragma("unroll") for (int i = 0; i < 8; ++i) { const int p = 256 * (J) + kidx + 16 * (8 * (HF) + i); const int page = ptab[p >> 7]; \
        VV[i] = __builtin_nontemporal_load((const f32x4*)(vc + (((size_t)page * 128 + (p & 127)) * 4 + h) * 64 + 4 * sub)); } } while (0)
    int jcur = __builtin_ctz(vmask); vmask &= vmask - 1u;
    MS_LOADV(vA, jcur, 0); MS_LOADV(vB, jcur, 1);
    u32x2 vown = {0u, 0u};
    if (kidx < 4) vown = *(const u32x2*)(C.mv() + sbase + kidx * 64 + 4 * sub);
    {
        const int q = w; const unsigned sel = ((LAS unsigned*)ml)[8 + q];
        int blk[3]; { int n = 0;
#pragma unroll
            for (int j = 0; j < 8; ++j) if ((sel >> j) & 1u) { if (n == 0) blk[0] = j; else if (n == 1) blk[1] = j; else blk[2] = j; ++n; } }
        float vals[12];
        float mx = -1e30f;
#pragma unroll
        for (int i = 0; i < 12; ++i) { const int idx = lane + 64 * i; const int sl = idx >> 8; const int bj = (sl == 0) ? blk[0] : (sl == 1 ? blk[1] : blk[2]);
            vals[i] = sc[q * 2048 + 256 * bj + (idx & 255)]; mx = fmaxf(mx, vals[i]); }
        float ov = -1e30f;
        if (lane <= q) { ov = own[q * 4 + lane]; mx = fmaxf(mx, ov); }
        const float m = wave_max(mx);
        float s = 0.f;
#pragma unroll
        for (int i = 0; i < 12; ++i) s += __expf(vals[i] - m);
        if (lane <= q) s += __expf(ov - m);
        s = wave_sum(s);
        if (lane == 0) { ml[q] = m; ml[4 + q] = s; }
    }
    HBS_SEL(HB_MS);
    f32x4 acc[4];
#pragma unroll
    for (int q = 0; q < 4; ++q) acc[q] = (f32x4){0.f, 0.f, 0.f, 0.f};
    float mq_[4];
#pragma unroll
    for (int q = 0; q < 4; ++q) mq_[q] = ml[q];
#define MS_COMPV(VV, J, HF) do { float sf_[4]; _Pragma("unroll") for (int q = 0; q < 4; ++q) sf_[q] = (float)((selq[q] >> (J)) & 1u);     \
        _Pragma("unroll") for (int i = 0; i < 8; ++i) { const int p = 256 * (J) + kidx + 16 * (8 * (HF) + i); \
        _Pragma("unroll") for (int q = 0; q < 4; ++q) { const float wgt = __expf(fminf(sc[q * 2048 + p] - mq_[q], 0.f)) * sf_[q]; acc[q] = acc[q] + VV[i] * wgt; } } } while (0)
    for (;;) {
        MS_COMPV(vA, jcur, 0);
        int jn = -1;
        if (vmask) { jn = __builtin_ctz(vmask); vmask &= vmask - 1u; MS_LOADV(vA, jn, 0); }
        MS_COMPV(vB, jcur, 1);
        if (jn < 0) break;
        MS_LOADV(vB, jn, 1);
        jcur = jn;
    }
#undef MS_LOADV
#undef MS_COMPV
    if (kidx < 4) {
        const f32x4 vn = {bf2f(vown.x & 0xffffu), bf2f(vown.x >> 16), bf2f(vown.y & 0xffffu), bf2f(vown.y >> 16)};
#pragma unroll
        for (int q = 0; q < 4; ++q) { const float wgt = (kidx <= q) ? __expf(own[q * 4 + kidx] - mq_[q]) : 0.f; acc[q] = acc[q] + vn * wgt; }
    }
#pragma unroll
    for (int q = 0; q < 4; ++q)
#pragma unroll
        for (int i = 0; i < 4; ++i) { float v = acc[q][i]; v += __shfl_xor(v, 16); v += __shfl_xor(v, 32); acc[q][i] = v; }
    if (lane < 16) {
#pragma unroll
        for (int q = 0; q < 4; ++q) *(LAS f32x4*)(ored + (w * 4 + q) * 64 + 4 * sub) = acc[q];
    }
    HBS_SEL(HB_MS);
    { const int q = tid >> 6, d = tid & 63; float s = 0.f;
#pragma unroll
        for (int ww = 0; ww < 4; ++ww) s += ored[(ww * 4 + q) * 64 + d];
        C.mix()[((size_t)MP + 4 * b + q) * DM + 768 + h * 64 + d] = (bf16_t)f2bf(s / ml[4 + q]); }
    HBS_SEL(HB_MS);
}


__device__ __forceinline__ void km4_item(const Ctx& C, const int tl, int item, LAS unsigned char* lds, HalfBar& hb) {
    const int lane = tl & 63, w = tl >> 6, cg = tl & 7, r0 = tl >> 3;
    const int bh = item >> 3, j = item & 7;
    const bf16_t* kp = C.mk() + ((size_t)bh * SEQ + 256 * j + r0) * 64 + 8 * cg;
    u32x4 v[8];
#pragma unroll
    for (int i = 0; i < 8; ++i) v[i] = *(const u32x4*)(kp + (size_t)i * 32 * 64);
    float s[8];
#pragma unroll
    for (int e = 0; e < 8; ++e) s[e] = 0.f;
#pragma unroll
    for (int i = 0; i < 8; ++i) { s[0] += bf2f(v[i].x & 0xffffu); s[1] += bf2f(v[i].x >> 16); s[2] += bf2f(v[i].y & 0xffffu); s[3] += bf2f(v[i].y >> 16);
                                  s[4] += bf2f(v[i].z & 0xffffu); s[5] += bf2f(v[i].z >> 16); s[6] += bf2f(v[i].w & 0xffffu); s[7] += bf2f(v[i].w >> 16); }
#pragma unroll
    for (int e = 0; e < 8; ++e) { s[e] += __shfl_xor(s[e], 8); s[e] += __shfl_xor(s[e], 16); s[e] += __shfl_xor(s[e], 32); }
    LAS float* red = (LAS float*)lds;
    if (lane < 8) {
#pragma unroll
        for (int e = 0; e < 8; ++e) red[w * 64 + 8 * lane + e] = s[e];
    }
    HBS_SEL(HB_KM);
    if (tl < 64) C.km()[((size_t)bh * 16 + j) * 64 + tl] = (bf16_t)f2bf(((red[tl] + red[64 + tl]) + (red[128 + tl] + red[192 + tl])) * (1.0f / 256.0f));
    HBS_SEL(HB_KM);
}

__device__ __forceinline__ void scv4_all(const Ctx& C, const int tl, int l, const int lo = 0, const int hi = MT * 128) {
    const float* cw = C.sc_conv_w() + (size_t)l * 3 * 256;
    constexpr int U = 4;
    const int stride = C.G * 256;
    for (int idx0 = lo + C.wg * 256 + tl; idx0 < hi; idx0 += U * stride) {
        unsigned A[U][3], B[U][3], gg[U];
#pragma unroll
        for (int k = 0; k < U; ++k) {
            const int idx = idx0 + k * stride; const bool valid = idx < hi;
            const int row = idx >> 7, c2 = (idx & 127) * 2;
            const bool samp = row >= MP; const int sr = row - MP;
            const int b = samp ? (sr >> 2) : (row >> 11), t = samp ? (sr & 3) : (row & 2047);
#pragma unroll
            for (int i = 0; i < 3; ++i) {
                const int tt = t - 2 + i;
                A[k][i] = 0u; B[k][i] = 0u;
                if (valid && tt >= 0) { const bf16_t* p = C.sc() + (size_t)(row - 2 + i) * 768 + c2; A[k][i] = *(const unsigned*)p; B[k][i] = *(const unsigned*)(p + 256); }
                else if (valid && samp) { const float* hp = C.state_sconv() + ((size_t)(l * 128 + b) * 2 + (tt + 2)) * 256 + c2; A[k][i] = __float_as_uint(hp[0]); B[k][i] = __float_as_uint(hp[1]); }
            }
            gg[k] = valid ? *(const unsigned*)(C.sc() + (size_t)row * 768 + 512 + c2) : 0u;
        }
#pragma unroll
        for (int k = 0; k < U; ++k) {
            const int idx = idx0 + k * stride;
            if (idx < hi) {
                const int row = idx >> 7, c2 = (idx & 127) * 2;
                const bool samp = row >= MP; const int sr = row - MP;
                const int b = samp ? (sr >> 2) : (row >> 11), t = samp ? (sr & 3) : (row & 2047);
                float ch[3][2];
#pragma unroll
                for (int i = 0; i < 3; ++i) {
                    const int tt = t - 2 + i;
                    if (tt >= 0) { ch[i][0] = bf2f(A[k][i] & 0xffffu) * bf2f(B[k][i] & 0xffffu); ch[i][1] = bf2f(A[k][i] >> 16) * bf2f(B[k][i] >> 16); }
                    else { ch[i][0] = __uint_as_float(A[k][i]); ch[i][1] = __uint_as_float(B[k][i]); }
                }
                const float y0 = cw[c2] * ch[0][0] + cw[256 + c2] * ch[1][0] + cw[512 + c2] * ch[2][0];
                const float y1 = cw[c2 + 1] * ch[0][1] + cw[256 + c2 + 1] * ch[1][1] + cw[512 + c2 + 1] * ch[2][1];
                *(unsigned*)(C.mix() + (size_t)row * DM + 512 + c2) = pk2(bf2f(gg[k] & 0xffffu) * y0, bf2f(gg[k] >> 16) * y1);
                const int j = samp ? (t - 2) : (t - 2046);
                if (j >= 0) { float* o = C.out + (samp ? (O_SSCONV + ((size_t)(l * 128 + b) * 2 + j) * 256) : (O_PSCONV + ((size_t)(l * 8 + b) * 2 + j) * 256)) + c2; o[0] = ch[2][0]; o[1] = ch[2][1]; }
            }
        }
    }
}


#ifndef ONLY
#define ONLY -1
#endif
#ifndef SUB
#define SUB -1
#endif
#define PHEN(k) (ONLY < 0 || ONLY == (k))
#define G3_PAIR(it) ((C.G == 256) ? (64 * ((it) & 7) + 32 * ((it) >> 8) + (((it) & 255) >> 3)) : (it))
#define G1_ITEM(it) ((C.G == 256) ? (2 * G3_PAIR(((it) & 255) + 256 * ((it) >> 9)) + (((it) >> 8) & 1)) : (it))
#ifndef HALF_A_PRIO
#define HALF_A_PRIO 3
#endif
#ifndef SCV_SPLIT
#define SCV_SPLIT (MT * 128)
#endif
#ifndef GS_SPLIT
#define GS_SPLIT 512
#endif
constexpr int GU_NFULL = ((MT / 256) * (NGU / 256)) % 256, IN_NFULL = ((MT / 256) * (NIN / 256)) % 256;
#ifndef HREPS
#define HREPS 1,1,1,1,1
#endif
constexpr int HREP_[5] = {HREPS};
#define HREP_G1 HREP_[0]
#define HREP_KM HREP_[1]
#define HREP_SCV HREP_[2]
#define HREP_MS HREP_[3]
#define HREP_GS HREP_[4]
#ifndef REPS
#define REPS 1,1,1,1,1,1,1,1,1,1,1,1,1,1
#endif
constexpr int REP[14] = {REPS};
#define SUBEN(k) (SUB < 0 || SUB == (k))
constexpr int N_PHASES = 20;

__global__ void __launch_bounds__(512, 2) mk_fwd(Params p) {
    extern __shared__ __attribute__((aligned(16))) unsigned char lds_raw[];
    LAS unsigned char* lds = (LAS unsigned char*)lds_raw;
    volatile LAS unsigned* MISC = (volatile LAS unsigned*)(lds + MISC_OFF);
    const int tid = threadIdx.x;
#define PH_BEGIN() int tidp = threadIdx.x; asm volatile("" : "+v"(tidp)); Ctx Cp = C; { size_t zoff_ = 0; asm volatile("" : "+s"(zoff_), "+s"(Cp.wg), "+s"(Cp.G)); Cp.ws = C.ws + zoff_; Cp.P = (const __attribute__((address_space(4))) Params*)((const __attribute__((address_space(4))) char*)C.P + zoff_); }
    Ctx C;
    C.P = (const __attribute__((address_space(4))) Params*)__builtin_amdgcn_kernarg_segment_ptr(); C.ws = p.ws; C.out = p.out;
    unsigned char* ws = p.ws;
    C.G = gridDim.x; C.wg = blockIdx.x;

    for (int u = tid; u < (LDS_BYTES - 131072) / 4; u += 512) ((LAS unsigned*)(lds + 131072))[u] = 0u;
    __syncthreads();
    int lo = p.ph_lo, hi = p.ph_hi;
    const bool one = (hi - lo) > 1;
    XcdBarrier bar; bar.bar = (unsigned*)(ws + WS_CTL) + CW_BAR; bar.x = 0; bar.st = nullptr;
    if (one) bar = xcd_barrier_post((unsigned*)(ws + WS_CTL) + CW_BAR, MISC + 8);
#define IN(k) (lo <= (k) && (k) < hi)
#define SEAM(k) do { if (IN(k) && IN((k) + 1)) { XcdBarrier b2_ = bar; size_t zb_ = 0; asm volatile("" : "+s"(zb_), "+s"(b2_.x)); b2_.bar = bar.bar + zb_; xcd_barrier(b2_); } } while (0)

    if (PHEN(100) && IN(0)) { for (int rep = 0; rep < REP[0]; ++rep) { PH_BEGIN(); p0_prologue(Cp, tidp, lds); } }
    SEAM(0);
    for (int l = 0; l < 2; ++l) {
        const int base = 1 + 9 * l;
        asm volatile("" : "+s"(lo), "+s"(hi));

        if (PHEN(0) && IN(base + 0)) for (int rep = 0; rep < REP[1]; ++rep) {
            PH_BEGIN();
            pg8::Gemm g{Cp.xb(), (const bf16_t*)(Cp.ws + WS_W + (size_t)l * W_LAYER + WO_GU1), MT, NGU, DM}; pg8::StaticOrder S; S.init(MT, NGU, Cp.G, Cp.wg);
            rstd_table(S, Cp.ssq(), lds, tidp); pg8::EpiGU E{(const LAS float*)(lds + RTAB_OFF), Cp.hid()};
            pg8::gemm_phase<pg8::EpiGU, pg8::StaticOrder, true, true>(lds, g, S, E, tidp);
            if (l == 0 && conv_deferred(Cp)) { PH_BEGIN(); conv_slot_a(Cp, tidp, lds); }
            if (l == 1 && conv_deferred(Cp)) { PH_BEGIN(); conv_slot(Cp, tidp, (int)Cp.wg - GU_NFULL, 256 - GU_NFULL, I_LAYER + I_GU, I_LAYER + I_GU + I_DN + I_IN + I_OUT, lds); }
        }
        SEAM(base + 0);
        if (PHEN(1) && IN(base + 1)) {
            PH_BEGIN();
            pg8::Gemm g{Cp.hid(), (const bf16_t*)(Cp.ws + WS_W + (size_t)l * W_LAYER + WO_DN1), MP, DM, FF}; pg8::StaticOrder S; S.init(MP, DM, Cp.G, Cp.wg);
            for (int rep = 1; rep < REP[12]; ++rep) { pg8::EpiNull EN{Cp.ssq()}; pg8::gemm_phase<pg8::EpiNull, pg8::StaticOrder, true, true>(lds, g, S, EN, tidp); }
            pg8::EpiRES E{Cp.xres(), Cp.xb(), Cp.ssq(), 0.5f};
            pg8::gemm_phase<pg8::EpiRES, pg8::StaticOrder, true, true>(lds, g, S, E, tidp);
            { PH_BEGIN(); sample_gemm_res<FF>(Cp, tidp, Cp.hid() + (size_t)MP * FF, (const bf16_t*)(Cp.ws + WS_W + (size_t)l * W_LAYER + WO_DN1), 0.5f, lds); }
        }
        SEAM(base + 1);
        if (PHEN(2) && IN(base + 2)) for (int rep = 0; rep < REP[2]; ++rep) {
            PH_BEGIN();
            pg8::Gemm g{Cp.xb(), (const bf16_t*)(Cp.ws + WS_W + (size_t)l * W_LAYER + WO_IN), MT, NIN, DM}; pg8::StaticOrder S; S.init(MT, NIN, Cp.G, Cp.wg);
            rstd_table(S, Cp.ssq(), lds, tidp); pg8::EpiIN E{Cp.ws, Cp.out, l, (const LAS float*)(lds + RTAB_OFF)};
            pg8::gemm_phase<pg8::EpiIN, pg8::StaticOrder, true, true>(lds, g, S, E, tidp);
            { PH_BEGIN(); ba_rows(Cp, tidp, l); }
            if (conv_deferred(Cp)) { PH_BEGIN(); const int o_gu2 = I_LAYER + 2 * I_GU + I_DN + I_IN + I_OUT - I_GU;
                conv_slot(Cp, tidp, (int)Cp.wg - IN_NFULL, 256 - IN_NFULL, l == 0 ? o_gu2 : o_gu2 + I_GU, l == 0 ? o_gu2 + I_GU : 2 * I_LAYER, lds); }
        }
        SEAM(base + 2);
        if (PHEN(3) && IN(base + 3)) {
            int tid3 = threadIdx.x; asm volatile("" : "+v"(tid3));
            const int w8 = __builtin_amdgcn_readfirstlane(tid3 >> 6);
            LAS unsigned* hslots = (LAS unsigned*)(lds + MISC_OFF + 128) + (w8 >> 2) * 16;
            LDS_BARRIER();
            HalfBar hb; hb.slots = hslots; hb.w = w8 & 3; hb.gen = 0u; *(volatile LAS unsigned*)(hslots + (w8 & 3)) = 0u;
            LDS_BARRIER();
            if (w8 < 4) {
                __builtin_amdgcn_s_setprio(HALF_A_PRIO);
                for (int ra = 0; ra < HREP_G1; ++ra) for (int it = C.wg; it < 1024; it += C.G) { PH_BEGIN(); g1h_chunk(Cp, tidp & 255, l, G1_ITEM(it), lds, hb); }
                for (int ra = 0; ra < HREP_KM; ++ra) for (int it = C.wg; it < 256; it += C.G) { PH_BEGIN(); km4_item(Cp, tidp & 255, it, lds, hb); }
                for (int ra = 0; ra < HREP_SCV; ++ra) { PH_BEGIN(); scv4_all(Cp, tidp & 255, l); }
                for (int it = GS_SPLIT + C.wg; it < 512; it += C.G) { PH_BEGIN(); gs4_item(Cp, tidp & 255, l, it, lds, hb); }
                __builtin_amdgcn_s_setprio(0);
            } else {
                for (int rb = 0; rb < HREP_MS; ++rb) for (int it = C.wg; it < 512; it += C.G) { PH_BEGIN(); ms4_item(Cp, tidp & 255, l, it, lds + H_B, hb); }
                for (int rb = 0; rb < HREP_GS; ++rb) for (int it = C.wg; it < GS_SPLIT; it += C.G) { PH_BEGIN(); gs4_item(Cp, tidp & 255, l, it, lds + H_B, hb); }
            }
        }
        SEAM(base + 3);
        if (PHEN(4) && IN(base + 4)) { for (int rep = 0; rep < REP[8]; ++rep) { const int xcd_ = C.wg & 7, idx_ = C.wg >> 3;
              if (C.G == 256) { if (idx_ < 16) { PH_BEGIN(); g2_scan(Cp, tidp, l, (4 * xcd_ + (idx_ >> 2)) * 4 + (idx_ & 3), lds); } }
              else for (int it = C.wg; it < 128; it += C.G) { PH_BEGIN(); g2_scan(Cp, tidp, l, it, lds); } } }
        if (PHEN(5) && IN(base + 4)) {
            if (C.G == 256) {
                const int x_ = C.wg & 7, idx_ = C.wg >> 3;
                for (int rep = 0; rep < REP[9]; ++rep) {
                    if (idx_ < 16) { PH_BEGIN(); moba_prompt_item(Cp, tidp, 4 * x_ + (idx_ >> 2), 6 + (idx_ & 3), lds); }
                    else {
                        const int i2 = idx_ - 16, t_ = i2 & 3;
                        const int packed = (t_ == 0) ? (15 | (5 << 4) | (2 << 8)) : (t_ == 1) ? (14 | (4 << 4) | (3 << 8)) : (t_ == 2) ? (13 | (10 << 4) | (0 << 8)) : (12 | (11 << 4) | (1 << 8));
                        for (int k = 0; k < 3; ++k) { PH_BEGIN(); moba_prompt_item(Cp, tidp, 4 * x_ + (i2 >> 2), (packed >> (4 * k)) & 15, lds); }
                    }
                }
            } else
            for (int rep = 0; rep < REP[9]; ++rep) for (int it = C.wg; it < 512; it += C.G) {
                const int v_ = (C.G == 256) ? ((it & 7) * 32 + ((it & 255) >> 3)) : (it & 255); const int bh = v_ >> 3, qq = v_ & 7; PH_BEGIN(); moba_prompt_item(Cp, tidp, bh, (it < 256) ? qq : 15 - qq, lds); }
        }
        SEAM(base + 4);
        if (PHEN(6) && IN(base + 5)) { for (int rep = 0; rep < REP[10]; ++rep) for (int it = C.wg; it < 512; it += C.G) { PH_BEGIN(); g3_pair(Cp, tidp, l, G3_PAIR(it), lds); } }
        SEAM(base + 5);
        if (PHEN(7) && IN(base + 6)) {
            PH_BEGIN();
            pg8::Gemm g{Cp.mix(), (const bf16_t*)(Cp.ws + WS_W + (size_t)l * W_LAYER + WO_OUT), MP, DM, DM}; pg8::StaticOrder S; S.init(MP, DM, Cp.G, Cp.wg);
            for (int rep = 1; rep < REP[13]; ++rep) { pg8::EpiNull EN{Cp.ssq()}; pg8::gemm_phase<pg8::EpiNull, pg8::StaticOrder, true, true>(lds, g, S, EN, tidp); }
            pg8::EpiRES E{Cp.xres(), Cp.xb(), Cp.ssq(), 1.0f};
            pg8::gemm_phase<pg8::EpiRES, pg8::StaticOrder, true, true>(lds, g, S, E, tidp);
            { PH_BEGIN(); sample_gemm_res<DM>(Cp, tidp, Cp.mix() + (size_t)MP * DM, (const bf16_t*)(Cp.ws + WS_W + (size_t)l * W_LAYER + WO_OUT), 1.0f, lds); }
        }
        SEAM(base + 6);
        if (PHEN(8) && IN(base + 7)) {
            PH_BEGIN();
            pg8::Gemm g{Cp.xb(), (const bf16_t*)(Cp.ws + WS_W + (size_t)l * W_LAYER + WO_GU2), MT, NGU, DM}; pg8::StaticOrder S; S.init(MT, NGU, Cp.G, Cp.wg);
            rstd_table(S, Cp.ssq(), lds, tidp); pg8::EpiGU E{(const LAS float*)(lds + RTAB_OFF), Cp.hid()};
            pg8::gemm_phase<pg8::EpiGU, pg8::StaticOrder, true, true>(lds, g, S, E, tidp);
            if (l == 0 && conv_deferred(Cp)) { PH_BEGIN(); conv_slot(Cp, tidp, (int)Cp.wg - GU_NFULL, 256 - GU_NFULL, I_LATE0, I_LAYER + I_GU, lds); }
        }
        SEAM(base + 7);
        if (PHEN(9) && IN(base + 8)) {
            PH_BEGIN();
            pg8::Gemm g{Cp.hid(), (const bf16_t*)(Cp.ws + WS_W + (size_t)l * W_LAYER + WO_DN2), MP, DM, FF}; pg8::StaticOrder S; S.init(MP, DM, Cp.G, Cp.wg);
            pg8::EpiRES E{Cp.xres(), Cp.xb(), Cp.ssq(), 0.5f};
            pg8::gemm_phase<pg8::EpiRES, pg8::StaticOrder, true, true>(lds, g, S, E, tidp);
            { PH_BEGIN(); sample_gemm_res<FF>(Cp, tidp, Cp.hid() + (size_t)MP * FF, (const bf16_t*)(Cp.ws + WS_W + (size_t)l * W_LAYER + WO_DN2), 0.5f, lds); }
        }
        SEAM(base + 8);
    }
    if (PHEN(21) && IN(19)) { for (int rep = 0; rep < REP[11]; ++rep) { PH_BEGIN(); final_norm(Cp, tidp); } }
#undef IN
#undef SEAM
}

extern "C" void kernel_launch(void* const* d_in, const int* in_sizes, int n_in, void* d_out, int out_size, void* d_ws, size_t ws_size, hipStream_t stream) {
    static int grid = 0;
    if (grid == 0) {
        if (n_in != 25 || (size_t)out_size != O_END || ws_size < WS_END) { fprintf(stderr, "kernel_launch: unexpected shapes (n_in %d, out %d, ws %zu)\n", n_in, out_size, ws_size); grid = -1; return; }
        int dev = 0, cus = 0, per_cu = 0;
        if (hipGetDevice(&dev) != hipSuccess || hipDeviceGetAttribute(&cus, hipDeviceAttributeMultiprocessorCount, dev) != hipSuccess) { grid = -1; return; }
        if (hipFuncSetAttribute((const void*)mk_fwd, hipFuncAttributeMaxDynamicSharedMemorySize, LDS_BYTES) != hipSuccess) { fprintf(stderr, "kernel_launch: hipFuncSetAttribute failed\n"); grid = -1; return; }
        if (hipOccupancyMaxActiveBlocksPerMultiprocessor(&per_cu, (const void*)mk_fwd, 512, LDS_BYTES) != hipSuccess || per_cu < 1)
            fprintf(stderr, "kernel_launch: occupancy query reports %d workgroups per CU\n", per_cu);
        (void)hipGetLastError();
        grid = cus;
    }
    if (grid < 0) return;
    (void)hipMemsetAsync((char*)d_ws + WS_CTL, 0, CTL_ZERO_BYTES, stream);
    Params a{};
    for (int i = 0; i < 25; ++i) a.in[i] = d_in[i];
    a.out = (float*)d_out; a.ws = (unsigned char*)d_ws;
#if MK_ONE_LAUNCH
    a.ph_lo = 0; a.ph_hi = N_PHASES;
    hipLaunchKernelGGL(mk_fwd, dim3(grid), dim3(512), LDS_BYTES, stream, a);
#else
    for (int ph = 0; ph < N_PHASES; ++ph) { a.ph_lo = ph; a.ph_hi = ph + 1; hipLaunchKernelGGL(mk_fwd, dim3(grid), dim3(512), LDS_BYTES, stream, a); }
#endif
}
```
